# Optimizing an MI355X kernel written in HIP

```python
import math
import jax, jax.numpy as jnp
from jax import lax
import numpy as np

D_MODEL = 1024
BATCH = 4
SEQ = 4096
DEPTH = 2

HEAD_DIM = 64
N_GROUPS = 4
GROUP_WIDTH = D_MODEL // N_GROUPS
N_GROUP_HEADS = GROUP_WIDTH // HEAD_DIM
N_IN_SLICES = 13
D_IN = N_IN_SLICES * GROUP_WIDTH
D_FF = 4 * D_MODEL
CONV_WIDTH = 4
RG_LRU_C = 8.0
RET_CHUNK = 128
HGRN_CHUNK = 64
SB_BLOCK = 128
ROPE_BASE = 10000.0
LN_EPS = 1e-5
NORM_EPS = 1e-6
GATE_FLOOR = 1e-30
DEEPNORM_ALPHA = (2 * DEPTH) ** 0.25
DEEPNORM_BETA = (8 * DEPTH) ** -0.25

kernel_name = "hybrid_rglru_retention_stickbreak_hgrn2"


def layer_norm(x, g, b):
    x = x.astype(jnp.float32)
    mu = jnp.mean(x, axis=-1, keepdims=True)
    var = jnp.mean(jnp.square(x - mu), axis=-1, keepdims=True)
    return (x - mu) * lax.rsqrt(var + LN_EPS) * g + b


def split_heads(t):
    b, s, _ = t.shape
    return t.reshape(b, s, N_GROUP_HEADS, HEAD_DIM).transpose(0, 2, 1, 3)


def merge_heads(t):
    b, h, s, d = t.shape
    return t.transpose(0, 2, 1, 3).reshape(b, s, h * d)


def rotary(t, cos, sin):
    half = HEAD_DIM // 2
    t1, t2 = t[..., :half], t[..., half:]
    return jnp.concatenate([t1 * cos - t2 * sin, t1 * sin + t2 * cos], axis=-1)


def rglru_mixer(xa, ga, conv_w, conv_b, wa, ba, wx, bx, lam):
    b_, s_, _ = xa.shape
    xc = lax.conv_general_dilated(
        xa, conv_w.astype(xa.dtype)[:, None, :], window_strides=(1,),
        padding=[(CONV_WIDTH - 1, 0)], dimension_numbers=("NWC", "WIO", "NWC"),
        feature_group_count=GROUP_WIDTH) + conv_b
    xh = xc.reshape(b_, s_, N_GROUP_HEADS, HEAD_DIM)
    r = jax.nn.sigmoid(jnp.einsum("bshi,hij->bshj", xh, wa) + ba).reshape(b_, s_, GROUP_WIDTH)
    i = jax.nn.sigmoid(jnp.einsum("bshi,hij->bshj", xh, wx) + bx).reshape(b_, s_, GROUP_WIDTH)
    log_a = RG_LRU_C * r * jax.nn.log_sigmoid(lam)
    a = jnp.exp(log_a)
    u = jnp.sqrt(jnp.maximum(-jnp.expm1(2.0 * log_a), 0.0)) * (i * xc)

    def combine(left, right):
        a1, b1 = left
        a2, b2 = right
        return a1 * a2, a2 * b1 + b2

    _, h = lax.associative_scan(combine, (a, u), axis=1)
    return jax.nn.gelu(ga) * h


def retention_mixer(q, k, v, g, norm_g, cos, sin):
    q = rotary(split_heads(q), cos, sin)
    k = rotary(split_heads(k), cos, sin) * HEAD_DIM ** -0.5
    v = split_heads(v)
    b_, h_, s_, d_ = q.shape
    c_ = RET_CHUNK
    n_ = s_ // c_
    log_gamma = jnp.log1p(-jnp.exp2(-5.0 - jnp.arange(N_GROUP_HEADS, dtype=jnp.float32)))
    qc = q.reshape(b_, h_, n_, c_, d_)
    kc = k.reshape(b_, h_, n_, c_, d_)
    vc = v.reshape(b_, h_, n_, c_, d_)
    pos = jnp.arange(c_, dtype=jnp.float32)
    diff = pos[:, None] - pos[None, :]
    decay = jnp.where(diff >= 0, jnp.exp(log_gamma[:, None, None] * jnp.maximum(diff, 0.0)), 0.0)
    scores = jnp.einsum("bhnid,bhnjd->bhnij", qc, kc) * decay[:, None]
    o_intra = jnp.einsum("bhnij,bhnjd->bhnid", scores, vc)
    k_decay = jnp.exp(log_gamma[:, None] * (c_ - 1.0 - pos))
    chunk_kv = jnp.einsum("bhnjd,bhnje->bhnde", kc * k_decay[:, None, :, None], vc)
    chunk_decay = jnp.exp(log_gamma * c_)[None, :, None, None]

    def step(state, kv):
        return chunk_decay * state + kv, state

    init = jnp.zeros((b_, h_, d_, d_), chunk_kv.dtype)
    _, prev = lax.scan(step, init, jnp.moveaxis(chunk_kv, 2, 0))
    prev = jnp.moveaxis(prev, 0, 2)
    q_decay = jnp.exp(log_gamma[:, None] * (pos + 1.0))
    o_inter = jnp.einsum("bhnid,bhnde->bhnie", qc * q_decay[:, None, :, None], prev)
    o = (o_intra + o_inter).reshape(b_, h_, s_, d_).astype(jnp.float32)
    mu = jnp.mean(o, axis=-1, keepdims=True)
    var = jnp.mean(jnp.square(o - mu), axis=-1, keepdims=True)
    o = merge_heads((o - mu) * lax.rsqrt(var + NORM_EPS)) * norm_g
    return jax.nn.silu(g) * o


def stick_breaking_mixer(q, k, v):
    q, k, v = split_heads(q), split_heads(k), split_heads(v)
    b_, h_, s_, d_ = q.shape
    nb = s_ // SB_BLOCK
    q_blocks = jnp.moveaxis(q.reshape(b_, h_, nb, SB_BLOCK, d_), 2, 0)
    key_pos = jnp.arange(s_)
    scale = d_ ** -0.5

    def block(args):
        qb, n = args
        q_pos = n * SB_BLOCK + jnp.arange(SB_BLOCK)
        z = (jnp.einsum("bhqd,bhkd->bhqk", qb, k) * scale).astype(jnp.float32)
        mask = key_pos[None, :] < q_pos[:, None]
        log_keep = jnp.where(mask, jax.nn.log_sigmoid(-z), 0.0)
        later = lax.cumsum(log_keep, axis=3, reverse=True) - log_keep
        log_w = jnp.where(mask, jax.nn.log_sigmoid(z) + later, -1e4)
        w = jnp.where(mask, jnp.exp(log_w), 0.0)
        return jnp.einsum("bhqk,bhkd->bhqd", w.astype(v.dtype), v)

    o = lax.map(block, (q_blocks, jnp.arange(nb)))
    o = jnp.moveaxis(o, 0, 2).reshape(b_, h_, s_, d_)
    return merge_heads(o)


def hgrn2_mixer(q, f_pre, v, g, lower_bound, norm_g):
    q, f_pre, v = split_heads(q), split_heads(f_pre), split_heads(v)
    b_, h_, s_, d_ = q.shape
    c_ = HGRN_CHUNK
    n_ = s_ // c_
    lb = lower_bound.astype(jnp.float32).reshape(h_, d_)[None, :, None, :]
    f_pre = f_pre.astype(jnp.float32)
    f_gate = lb + (1.0 - lb) * jax.nn.sigmoid(f_pre)
    log_f = jnp.log(jnp.maximum(f_gate, GATE_FLOOR))
    k = (1.0 - lb) * jax.nn.sigmoid(-f_pre)
    to_chunks = lambda t: jnp.moveaxis(t.reshape(b_, h_, n_, c_, d_), 2, 0)
    bcum = jnp.cumsum(log_f.reshape(b_, h_, n_, c_, d_), axis=3)
    qs, ks, vs, bs = to_chunks(q), to_chunks(k), to_chunks(v), jnp.moveaxis(bcum, 2, 0)
    causal = jnp.tril(jnp.ones((c_, c_), dtype=bool))[:, :, None]

    def step(state, inp):
        qc, kc, vc, bc = inp
        diff = bc[:, :, :, None, :] - bc[:, :, None, :, :]
        w = jnp.where(causal, jnp.exp(jnp.minimum(diff, 0.0)), 0.0)
        attn = jnp.einsum("bhtd,bhtsd,bhsd->bhts", qc, w, kc)
        o = jnp.einsum("bhts,bhse->bhte", attn, vc) + jnp.einsum("bhtd,bhde->bhte", qc * jnp.exp(bc), state)
        b_last = bc[:, :, -1:, :]
        new_state = jnp.exp(b_last[:, :, 0, :])[..., None] * state + jnp.einsum(
            "bhsd,bhse->bhde", kc * jnp.exp(b_last - bc), vc)
        return new_state, o

    init = jnp.zeros((b_, h_, d_, d_), jnp.float32)
    _, o = lax.scan(step, init, (qs.astype(jnp.float32), ks, vs.astype(jnp.float32), bs))
    o = jnp.moveaxis(o, 0, 2).reshape(b_, h_, s_, d_).astype(jnp.float32)
    o = o * lax.rsqrt(jnp.mean(jnp.square(o), axis=-1, keepdims=True) + NORM_EPS)
    return merge_heads(o) * norm_g * jax.nn.silu(g)


def setup_inputs(seed: int = 0) -> dict:
    key = jax.random.key(seed)
    ks = jax.random.split(key, 24)
    f32 = jnp.float32
    nrm = lambda k, shape, s: jax.random.normal(k, shape, f32) * s
    lam_u = jax.random.uniform(ks[10], (DEPTH, GROUP_WIDTH), f32, minval=0.9, maxval=0.999)
    lam_p = lam_u ** (1.0 / RG_LRU_C)
    return {
        "x": jax.random.normal(ks[0], (BATCH, SEQ, D_MODEL), f32),
        "ln_in_g": 1.0 + nrm(ks[1], (D_MODEL,), 0.02),
        "ln_in_b": nrm(ks[2], (D_MODEL,), 0.02),
        "w_in": nrm(ks[3], (DEPTH, D_MODEL, D_IN), D_MODEL ** -0.5),
        "conv_w": nrm(ks[4], (DEPTH, CONV_WIDTH, GROUP_WIDTH), CONV_WIDTH ** -0.5),
        "conv_b": nrm(ks[5], (DEPTH, GROUP_WIDTH), 0.02),
        "rg_wa": nrm(ks[6], (DEPTH, N_GROUP_HEADS, HEAD_DIM, HEAD_DIM), HEAD_DIM ** -0.5),
        "rg_ba": nrm(ks[7], (DEPTH, N_GROUP_HEADS, HEAD_DIM), 0.1),
        "rg_wx": nrm(ks[8], (DEPTH, N_GROUP_HEADS, HEAD_DIM, HEAD_DIM), HEAD_DIM ** -0.5),
        "rg_bx": nrm(ks[9], (DEPTH, N_GROUP_HEADS, HEAD_DIM), 0.1),
        "rg_lambda": jnp.log(lam_p) - jnp.log1p(-lam_p),
        "ret_norm_g": 1.0 + nrm(ks[11], (DEPTH, GROUP_WIDTH), 0.02),
        "hgrn_lb_logits": nrm(ks[12], (DEPTH, GROUP_WIDTH), 0.5),
        "hgrn_norm_g": 1.0 + nrm(ks[13], (DEPTH, GROUP_WIDTH), 0.02),
        "w_out": nrm(ks[14], (DEPTH, D_MODEL, D_MODEL), D_MODEL ** -0.5 * DEEPNORM_BETA),
        "ln1_g": 1.0 + nrm(ks[15], (DEPTH, D_MODEL), 0.02),
        "ln1_b": nrm(ks[16], (DEPTH, D_MODEL), 0.02),
        "w_up": nrm(ks[17], (DEPTH, D_MODEL, D_FF), D_MODEL ** -0.5),
        "w_down": nrm(ks[18], (DEPTH, D_FF, D_MODEL), D_FF ** -0.5 * DEEPNORM_BETA),
        "ln2_g": 1.0 + nrm(ks[19], (DEPTH, D_MODEL), 0.02),
        "ln2_b": nrm(ks[20], (DEPTH, D_MODEL), 0.02),
    }


def reference(x, ln_in_g, ln_in_b, w_in, conv_w, conv_b, rg_wa, rg_ba, rg_wx, rg_bx, rg_lambda,
              ret_norm_g, hgrn_lb_logits, hgrn_norm_g, w_out, ln1_g, ln1_b, w_up, w_down,
              ln2_g, ln2_b):
    s_ = x.shape[1]
    inv_freq = ROPE_BASE ** (-jnp.arange(0, HEAD_DIM, 2, dtype=jnp.float32) / HEAD_DIM)
    ang = jnp.arange(s_, dtype=jnp.float32)[:, None] * inv_freq[None, :]
    cos, sin = jnp.cos(ang), jnp.sin(ang)
    lb_p = jax.nn.softmax(hgrn_lb_logits.astype(jnp.float32), axis=0)
    lower_bounds = jnp.cumsum(lb_p, axis=0) - lb_p[0]

    h = layer_norm(x, ln_in_g, ln_in_b)
    for l in range(DEPTH):
        proj = h @ w_in[l]
        (a_x, a_g, r_q, r_k, r_v, r_g, s_q, s_k, s_v,
         d_q, d_f, d_v, d_g) = jnp.split(proj, N_IN_SLICES, axis=-1)
        y_a = rglru_mixer(a_x, a_g, conv_w[l], conv_b[l], rg_wa[l], rg_ba[l], rg_wx[l], rg_bx[l], rg_lambda[l])
        y_b = retention_mixer(r_q, r_k, r_v, r_g, ret_norm_g[l], cos, sin)
        y_c = stick_breaking_mixer(s_q, s_k, s_v)
        y_d = hgrn2_mixer(d_q, d_f, d_v, d_g, lower_bounds[l], hgrn_norm_g[l])
        mix = jnp.concatenate([y_a, y_b, y_c, y_d], axis=-1) @ w_out[l]
        h = layer_norm(DEEPNORM_ALPHA * h + mix, ln1_g[l], ln1_b[l])
        ff = jnp.square(jax.nn.relu(h @ w_up[l])) @ w_down[l]
        h = layer_norm(DEEPNORM_ALPHA * h + ff, ln2_g[l], ln2_b[l])
    return h.astype(x.dtype)
```

```cpp
#include <hip/hip_runtime.h>
#include <hip/hip_cooperative_groups.h>
#include <cstdio>
#include <cstdint>
namespace cg = cooperative_groups;
namespace pg8 {
#define PG8_LAS __attribute__((address_space(3)))
typedef unsigned short bf16_t;
typedef short bf16x8 __attribute__((ext_vector_type(8)));
typedef float f32x4 __attribute__((ext_vector_type(4)));
typedef unsigned u32x4 __attribute__((ext_vector_type(4)));
constexpr int BM = 256, BK = 64, HALF = 128, HTB = HALF * BK * 2  , STAGE_BYTES = 8 * HTB, NXCD = 8, WGM = 8;

__host__ __device__ __forceinline__ int lds_byte(int r, int c) { const int st = (r >> 4) * 2 + (c >> 5), rr = r & 15, cc = c & 31, ob = rr * 64 + cc * 2; return st * 1024 + (ob ^ (((ob >> 9) & 1) << 5)); }
__host__ __device__ __forceinline__ void stage_rc(int b, int& R, int& C) { const int st = b / 1024, sb = b % 1024, swz = sb ^ (((sb >> 9) & 1) << 5); R = (st >> 1) * 16 + swz / 64; C = (st & 1) * 32 + (swz % 64) / 2; }
__host__ __device__ __forceinline__ int perm32(int rho) { const int n = rho >> 4, i = rho & 15; return 8 * (i >> 2) + 4 * n + (i & 3); }

struct Unit { int pm, pn; };
struct Gemm { const bf16_t* A; const bf16_t* Bt; int M, N, K; };

struct StaticOrder {
    int nM, nN, nwg, G, c;
    __host__ __device__ void init(int M, int N, int G_, int c_) { nM = M / BM; nN = N / BM; nwg = nM * nN; G = G_; c = c_; }
    __host__ __device__ bool next(int i, Unit& u) const {
        const long L = (long)i * G + c; if (L >= nwg) return false;
        int wgid = (int)L; { const int q = nwg / NXCD, r = nwg % NXCD, xcd = wgid % NXCD, off = wgid / NXCD; wgid = (xcd < r ? xcd * (q + 1) : r * (q + 1) + (xcd - r) * q) + off; }
        const int nig = WGM * nN, gid = wgid / nig, fm = gid * WGM, gsz = (nM - fm) < WGM ? (nM - fm) : WGM;
        u.pm = fm + ((wgid % nig) % gsz); u.pn = (wgid % nig) / gsz; return true;
    }
    __device__ __forceinline__ void a_ready(const Unit&) const {}
    __device__ __forceinline__ void done(const Unit&) const {}
};

__device__ __forceinline__ unsigned cvt_pk_bf16(float lo, float hi) { unsigned r; asm volatile("v_cvt_pk_bf16_f32 %0, %1, %2" : "=v"(r) : "v"(lo), "v"(hi)); return r; }
typedef float f32x2 __attribute__((ext_vector_type(2)));
__device__ __forceinline__ f32x2 gelu_pk(f32x2 v) {
    const f32x2 av = __builtin_elementwise_abs(v), d = av * 0.2316418882f + 1.0f;
    f32x2 t; t.x = __builtin_amdgcn_rcpf(d.x); t.y = __builtin_amdgcn_rcpf(d.y);
    f32x2 q = t * 0.5307027145f + (-0.7265760135f); q = q * t + 0.7107068705f; q = q * t + (-0.142248368f); q = q * t + 0.127414796f; q = q * t;
    const f32x2 s = (v * v) * (-0.72134752044f);
    f32x2 e; e.x = __builtin_amdgcn_exp2f(s.x); e.y = __builtin_amdgcn_exp2f(s.y);
    const f32x2 m = v * (q * e), r = v - m;
    f32x2 o; o.x = v.x < 0.f ? m.x : r.x; o.y = v.y < 0.f ? m.y : r.y; return o;
}

template <int ACT  > struct EpiBf16 {
    static constexpr bool PERM = true, AFTER_DRAIN = false; static_assert(ACT >= 0 && ACT <= 2, "EpiBf16: ACT is 0 (none), 1 (gelu_pk) or 2 (squared relu)");
    bf16_t* O; int ldc; const float* bias; int split_cols; size_t split_stride; float scale0;
    __device__ __forceinline__ void operator()(const f32x4 (&acc)[2][2][4][2], const Unit& u, int wr, int wc, int fr, int fq) const {
        const int row0 = u.pm * BM + wr * 64 + fr; int colt = u.pn * BM; bf16_t* base = O;
        float sc = 1.f; if (split_cols) { const int t = colt / split_cols; base += (size_t)t * split_stride; colt -= t * split_cols; if (t == 0) sc = scale0; }
        const int col0 = colt + wc * 32 + 8 * fq, bcol0 = u.pn * BM + wc * 32 + 8 * fq;
        f32x4 bv[2][2];
#pragma unroll
        for (int bj = 0; bj < 2; ++bj)
#pragma unroll
            for (int n = 0; n < 2; ++n) bv[bj][n] = bias ? *(const f32x4*)(bias + bcol0 + bj * HALF + 4 * n) : (f32x4){0.f, 0.f, 0.f, 0.f};
#pragma unroll
        for (int ai = 0; ai < 2; ++ai)
#pragma unroll
            for (int m = 0; m < 4; ++m) { bf16_t* rowp = base + (size_t)(row0 + ai * HALF + m * 16) * ldc + col0;
#pragma unroll
                for (int bj = 0; bj < 2; ++bj) { f32x4 v0 = acc[ai][bj][m][0] + bv[bj][0], v1 = acc[ai][bj][m][1] + bv[bj][1];
                    if (ACT == 1) { f32x2 a = gelu_pk((f32x2){v0[0], v0[1]}), b = gelu_pk((f32x2){v0[2], v0[3]}), c = gelu_pk((f32x2){v1[0], v1[1]}), d = gelu_pk((f32x2){v1[2], v1[3]});
                        v0 = (f32x4){a.x, a.y, b.x, b.y}; v1 = (f32x4){c.x, c.y, d.x, d.y}; }
                    if (ACT == 2) { v0 = __builtin_elementwise_max(v0, (f32x4){0.f, 0.f, 0.f, 0.f}); v1 = __builtin_elementwise_max(v1, (f32x4){0.f, 0.f, 0.f, 0.f}); v0 = v0 * v0; v1 = v1 * v1; }
                    v0 = v0 * sc; v1 = v1 * sc; u32x4 w; w.x = cvt_pk_bf16(v0[0], v0[1]); w.y = cvt_pk_bf16(v0[2], v0[3]); w.z = cvt_pk_bf16(v1[0], v1[1]); w.w = cvt_pk_bf16(v1[2], v1[3]);
                    *(u32x4*)(rowp + bj * HALF) = w; } }
    }
};

struct PanelStats {
    unsigned* xbuf;
    unsigned* cnt;
    unsigned* tmo;
    int ntn; float eps;
    unsigned code;
    __device__ __forceinline__ bool run(const f32x4 (&v)[2][2][4][2], const Unit& u, int wr, int wc, int fr, int fq, PG8_LAS unsigned char* lds, int wid, int lane) const {
        typedef float f32x2v __attribute__((ext_vector_type(2)));
        PG8_LAS f32x2v* P = (PG8_LAS f32x2v*)lds;
        PG8_LAS f32x2v* S = (PG8_LAS f32x2v*)(lds + 8192);
        PG8_LAS unsigned* flag = (PG8_LAS unsigned*)(lds + 8192 + 2048);
#pragma unroll
        for (int ai = 0; ai < 2; ++ai)
#pragma unroll
            for (int m = 0; m < 4; ++m) {
                float s = 0.f;
#pragma unroll
                for (int bj = 0; bj < 2; ++bj)
#pragma unroll
                    for (int n = 0; n < 2; ++n) { const f32x4 x = v[ai][bj][m][n]; s += (x[0] + x[1]) + (x[2] + x[3]); }
                s += __shfl_xor(s, 16); s += __shfl_xor(s, 32);
                const float mw = s * (1.0f / 64.0f); float q = 0.f;
#pragma unroll
                for (int bj = 0; bj < 2; ++bj)
#pragma unroll
                    for (int n = 0; n < 2; ++n) { const f32x4 d = v[ai][bj][m][n] - mw; q += (d[0] * d[0] + d[1] * d[1]) + (d[2] * d[2] + d[3] * d[3]); }
                q += __shfl_xor(q, 16); q += __shfl_xor(q, 32);
                if (fq == 0) P[(ai * HALF + wr * 64 + m * 16 + fr) * 4 + wc] = (f32x2v){mw, q};
            }
        asm volatile("s_waitcnt lgkmcnt(0)" ::: "memory"); __builtin_amdgcn_s_barrier(); asm volatile("" ::: "memory");
#if defined(BROKEN_EXCHANGE_NO_WAIT)
#warning BROKEN CONTROL BUILD: the row-statistics exchange does not wait; results are wrong by design
        if (blockIdx.x >= 64) { const long long t0_ = clock64(); while (clock64() - t0_ < 60000) __builtin_amdgcn_s_sleep(8); }
#endif
        const int row = wid * 32 + (lane & 31);
        if (lane < 32) {
            const f32x2v a = P[row * 4 + 0], b = P[row * 4 + 1], c = P[row * 4 + 2], d = P[row * 4 + 3];
            const float mt = (a.x + b.x + c.x + d.x) * 0.25f;
            const float da = a.x - mt, db = b.x - mt, dc = c.x - mt, dd = d.x - mt;
            const float m2 = (a.y + b.y) + (c.y + d.y) + 64.0f * ((da * da + db * db) + (dc * dc + dd * dd));
            unsigned long long* slot = (unsigned long long*)xbuf + ((size_t)(u.pm * BM + row) * 4 + u.pn);
            __hip_atomic_store(slot, ((unsigned long long)__float_as_uint(m2) << 32) | __float_as_uint(mt), __ATOMIC_RELAXED, __HIP_MEMORY_SCOPE_AGENT);
        }
        asm volatile("s_waitcnt vmcnt(0)" ::: "memory");
        if (lane == 0) __hip_atomic_fetch_add(cnt + 64 * u.pm, 1u, __ATOMIC_RELAXED, __HIP_MEMORY_SCOPE_AGENT);
        if (wid == 0) {
            bool dead = false; const unsigned long long t0 = __builtin_amdgcn_s_memrealtime(); const unsigned want = 8u * (unsigned)ntn;
            for (;;) {
#if defined(BROKEN_EXCHANGE_NO_WAIT)
                break;
#endif
                if ((unsigned)__builtin_amdgcn_readfirstlane(__hip_atomic_load(cnt + 64 * u.pm, __ATOMIC_RELAXED, __HIP_MEMORY_SCOPE_AGENT)) >= want) break;
                if (__builtin_amdgcn_s_memrealtime() - t0 > 2000000ull) {
                    if (lane == 0) { unsigned expect = 0u; __hip_atomic_compare_exchange_strong(tmo + 1, &expect, code | (unsigned)(u.pm & 0xff), __ATOMIC_RELAXED, __ATOMIC_RELAXED, __HIP_MEMORY_SCOPE_AGENT);
                                     __hip_atomic_store(tmo, 1u, __ATOMIC_RELAXED, __HIP_MEMORY_SCOPE_AGENT); }
                    dead = true; break; }
                __builtin_amdgcn_s_sleep(2);
            }
            __builtin_amdgcn_fence(__ATOMIC_ACQUIRE, "agent");
            if (lane == 0) flag[0] = dead ? 1u : 0u;
        }
        asm volatile("s_waitcnt vmcnt(0) lgkmcnt(0)" ::: "memory"); __builtin_amdgcn_s_barrier(); asm volatile("" ::: "memory");
        const bool bad = flag[0] != 0u;
        if (lane < 32) {
            const unsigned long long* slot = (const unsigned long long*)xbuf + (size_t)(u.pm * BM + row) * 4; float mt[4], m2[4]; float ms = 0.f;
#pragma unroll
            for (int t = 0; t < 4; ++t) { if (t < ntn) { const unsigned long long w = __hip_atomic_load(slot + t, __ATOMIC_RELAXED, __HIP_MEMORY_SCOPE_AGENT); mt[t] = __uint_as_float((unsigned)w); m2[t] = __uint_as_float((unsigned)(w >> 32)); } else { mt[t] = 0.f; m2[t] = 0.f; } ms += mt[t]; }
            const float mean = ms / (float)ntn; float q = 0.f;
#pragma unroll
            for (int t = 0; t < 4; ++t) if (t < ntn) { const float dm = mt[t] - mean; q += m2[t] + 256.0f * dm * dm; }
            S[row] = (f32x2v){mean, 1.0f / sqrtf(q / (256.0f * (float)ntn) + eps)};
        }
        asm volatile("s_waitcnt lgkmcnt(0)" ::: "memory"); __builtin_amdgcn_s_barrier(); asm volatile("" ::: "memory");
        return bad;
    }
};
struct EpiLnRes {
    static constexpr bool PERM = false, AFTER_DRAIN = true;
    const float* base; float* out; int ldc; const float* bias; PanelStats st; unsigned poison;
    __device__ __forceinline__ void fused(f32x4 (&acc)[2][2][4][2], const Unit& u, int wr, int wc, int fr, int fq, PG8_LAS unsigned char* lds, int wid, int lane) const {
        typedef float f32x2v __attribute__((ext_vector_type(2)));
        const PG8_LAS f32x2v* S = (const PG8_LAS f32x2v*)(lds + 8192);
        const int col0 = u.pn * BM + wc * 32 + 4 * fq;
#pragma unroll
        for (int bj = 0; bj < 2; ++bj)
#pragma unroll
            for (int n = 0; n < 2; ++n) { const f32x4 bv = bias ? *(const f32x4*)(bias + col0 + bj * HALF + n * 16) : (f32x4){0.f, 0.f, 0.f, 0.f};
#pragma unroll
                for (int ai = 0; ai < 2; ++ai)
#pragma unroll
                    for (int m = 0; m < 4; ++m) acc[ai][bj][m][n] += bv; }
        f32x4 pre[4][2][2];
#pragma unroll
        for (int m = 0; m < 4; ++m) { const size_t off = (size_t)(u.pm * BM + wr * 64 + m * 16 + fr) * ldc + col0;
#pragma unroll
            for (int bj = 0; bj < 2; ++bj)
#pragma unroll
                for (int n = 0; n < 2; ++n) pre[m][bj][n] = *(const f32x4*)(base + off + bj * HALF + n * 16); }
        const bool bad = st.run(acc, u, wr, wc, fr, fq, lds, wid, lane) || poison != 0u;
        const float qnan = __builtin_nanf("");
#pragma unroll
        for (int ai = 0; ai < 2; ++ai)
#pragma unroll
            for (int m = 0; m < 4; ++m) { const int r = ai * HALF + wr * 64 + m * 16 + fr; const f32x2v sr = S[r]; const size_t off = (size_t)(u.pm * BM + r) * ldc + col0;
#pragma unroll
                for (int bj = 0; bj < 2; ++bj)
#pragma unroll
                    for (int n = 0; n < 2; ++n) { const f32x4 bs = ai == 0 ? pre[m][bj][n] : *(const f32x4*)(base + off + bj * HALF + n * 16); f32x4 o = bs + (acc[ai][bj][m][n] - sr.x) * sr.y;
                        if (bad) o = (f32x4){qnan, qnan, qnan, qnan}; *(f32x4*)(out + off + bj * HALF + n * 16) = o; }
                if (m & 1) asm volatile("" ::: "memory"); }
    }
};
struct EpiLnResLn {
    static constexpr bool PERM = false, AFTER_DRAIN = true;
    const float* base; float* out; bf16_t* xn; int ldc; const float* bias; PanelStats st1, st2; unsigned poison;
    __device__ __forceinline__ void fused(f32x4 (&acc)[2][2][4][2], const Unit& u, int wr, int wc, int fr, int fq, PG8_LAS unsigned char* lds, int wid, int lane) const {
        typedef float f32x2v __attribute__((ext_vector_type(2))); typedef unsigned u32x2v __attribute__((ext_vector_type(2)));
        const PG8_LAS f32x2v* S = (const PG8_LAS f32x2v*)(lds + 8192);
        const int col0 = u.pn * BM + wc * 32 + 4 * fq;
#pragma unroll
        for (int bj = 0; bj < 2; ++bj)
#pragma unroll
            for (int n = 0; n < 2; ++n) { const f32x4 bv = bias ? *(const f32x4*)(bias + col0 + bj * HALF + n * 16) : (f32x4){0.f, 0.f, 0.f, 0.f};
#pragma unroll
                for (int ai = 0; ai < 2; ++ai)
#pragma unroll
                    for (int m = 0; m < 4; ++m) acc[ai][bj][m][n] += bv; }
        bool bad = st1.run(acc, u, wr, wc, fr, fq, lds, wid, lane) || poison != 0u;
        const float qnan = __builtin_nanf("");
#pragma unroll
        for (int ai = 0; ai < 2; ++ai)
#pragma unroll
            for (int m = 0; m < 4; ++m) { const int r = ai * HALF + wr * 64 + m * 16 + fr; const f32x2v sr = S[r]; const size_t off = (size_t)(u.pm * BM + r) * ldc + col0;
#pragma unroll
                for (int bj = 0; bj < 2; ++bj)
#pragma unroll
                    for (int n = 0; n < 2; ++n) { const f32x4 bs = *(const f32x4*)(base + off + bj * HALF + n * 16); acc[ai][bj][m][n] = bs + (acc[ai][bj][m][n] - sr.x) * sr.y; }
                asm volatile("" : "+v"(acc[ai][0][m][0]), "+v"(acc[ai][0][m][1]), "+v"(acc[ai][1][m][0]), "+v"(acc[ai][1][m][1]));
                if (m & 1) asm volatile("" ::: "memory"); }
        const bool bad1 = bad;
        bad = st2.run(acc, u, wr, wc, fr, fq, lds, wid, lane) || bad;
#pragma unroll
        for (int ai = 0; ai < 2; ++ai)
#pragma unroll
            for (int m = 0; m < 4; ++m) { const int r = ai * HALF + wr * 64 + m * 16 + fr; const f32x2v sr = S[r]; const size_t off = (size_t)(u.pm * BM + r) * ldc + col0;
#pragma unroll
                for (int bj = 0; bj < 2; ++bj)
#pragma unroll
                    for (int n = 0; n < 2; ++n) { const f32x4 x1 = acc[ai][bj][m][n]; *(f32x4*)(out + off + bj * HALF + n * 16) = bad1 ? (f32x4){qnan, qnan, qnan, qnan} : x1;
                        const f32x4 o = (x1 - sr.x) * sr.y; u32x2v w; w.x = cvt_pk_bf16(o[0], o[1]); w.y = cvt_pk_bf16(o[2], o[3]);
                        if (bad) { w.x = 0x7fc07fc0u; w.y = 0x7fc07fc0u; } *(u32x2v*)(xn + off + bj * HALF + n * 16) = w; }
                asm volatile("" ::: "memory"); }
    }
};

template <class Epi, class Sched, bool ALIGN_EPI = false, bool SP2 = false>
__device__ __forceinline__ void gemm_phase(PG8_LAS unsigned char* lds, const Gemm g, const Sched& S, const Epi& E) {
    int tid_l = threadIdx.x; asm volatile("" : "+v"(tid_l)); const int tid = tid_l, wid = __builtin_amdgcn_readfirstlane(tid >> 6), lane = tid & 63, wr = wid >> 2, wc = wid & 3, fr = lane & 15, fq = lane >> 4;
    const int K = g.K, nt = K / BK;
    unsigned voffA[2], voffB[2];
#pragma unroll
    for (int i = 0; i < 2; ++i) { int R, C; stage_rc(tid * 16 + i * 8192, R, C); const int Rb = Epi::PERM ? ((R & ~31) + perm32(R & 31)) : R;
        voffA[i] = (unsigned)(R * K + C) * 2u; voffB[i] = (unsigned)(Rb * K + C) * 2u; }
    const size_t kstep = (size_t)(BK * 2);
    const size_t hstep = (size_t)HALF * K * 2;
    const size_t tstep = 2 * hstep;
    const unsigned ldsw = (unsigned)wid * 1024u;
    const int aoff = lds_byte(wr * 64 + fr, fq * 8), boff = lds_byte(wc * 32 + fr, fq * 8);
#define PG8_SA(b, h) (((b) * 2 + (h)) * HTB)
#define PG8_SB(b, h) ((4 + (b) * 2 + (h)) * HTB)
#define PG8_STAGE(bufoff, gbase, voff) do { _Pragma("unroll") for (int _i = 0; _i < 2; ++_i) \
        __builtin_amdgcn_global_load_lds((const unsigned*)((const char*)(gbase) + (voff)[_i]), (PG8_LAS unsigned*)(lds + (bufoff) + ldsw + _i * 8192), 16, 0, 0); } while (0)
#define PG8_LDA(dst, b, h) do { _Pragma("unroll") for (int m = 0; m < 4; ++m) _Pragma("unroll") for (int k = 0; k < 2; ++k) dst[m][k] = *(const PG8_LAS bf16x8*)(lds + PG8_SA(b, h) + aoff + m * 2048 + k * 1024); } while (0)
#define PG8_LDB(dst, b, h) do { _Pragma("unroll") for (int n = 0; n < 2; ++n) _Pragma("unroll") for (int k = 0; k < 2; ++k) dst[n][k] = *(const PG8_LAS bf16x8*)(lds + PG8_SB(b, h) + boff + n * 2048 + k * 1024); } while (0)
#define PG8_MMA(ai, bj, At, Bt) do { __builtin_amdgcn_s_setprio(1); _Pragma("unroll") for (int m = 0; m < 4; ++m) _Pragma("unroll") for (int n = 0; n < 2; ++n) _Pragma("unroll") for (int k = 0; k < 2; ++k) \
        acc[ai][bj][m][n] = __builtin_amdgcn_mfma_f32_16x16x32_bf16(Bt[n][k], At[m][k], acc[ai][bj][m][n], 0, 0, 0); __builtin_amdgcn_s_setprio(0); } while (0)
#define PG8_WAIT_V(n) asm volatile("s_waitcnt vmcnt(" #n ")" ::: "memory")
#define PG8_WAIT_L(n) asm volatile("s_waitcnt lgkmcnt(" #n ")" ::: "memory")
#define PG8_BAR __builtin_amdgcn_s_barrier()
#define PG8_SCHED __builtin_amdgcn_sched_barrier(0)
    Unit cur, nxt; int ui = 0;
    if (!S.next(0, cur)) return;
    f32x4 acc[2][2][4][2];
#pragma unroll
    for (int a = 0; a < 2; ++a)
#pragma unroll
        for (int b = 0; b < 2; ++b)
#pragma unroll
            for (int m = 0; m < 4; ++m)
#pragma unroll
                for (int n = 0; n < 2; ++n) acc[a][b][m][n] = (f32x4){0.f, 0.f, 0.f, 0.f};
    bf16x8 At[4][2], B0[2][2], B1[2][2];
    const char* cA = (const char*)g.A + (size_t)cur.pm * tstep; const char* cB = (const char*)g.Bt + (size_t)cur.pn * tstep;
    S.a_ready(cur);
    if constexpr (SP2) {
        PG8_STAGE(PG8_SB(0, 0), cB, voffB); PG8_STAGE(PG8_SB(0, 1), cB + hstep, voffB); PG8_STAGE(PG8_SA(0, 0), cA, voffA); PG8_STAGE(PG8_SA(0, 1), cA + hstep, voffA);
        if (wr == 1) PG8_BAR;
        PG8_WAIT_V(2); PG8_BAR;
        PG8_STAGE(PG8_SB(1, 0), cB + kstep, voffB); PG8_STAGE(PG8_SA(1, 0), cA + kstep, voffA); PG8_STAGE(PG8_SB(1, 1), cB + hstep + kstep, voffB);
        PG8_WAIT_V(6); PG8_BAR;
    } else {
        PG8_STAGE(PG8_SB(0, 0), cB, voffB); PG8_STAGE(PG8_SA(0, 0), cA, voffA); PG8_STAGE(PG8_SB(0, 1), cB + hstep, voffB); PG8_STAGE(PG8_SA(0, 1), cA + hstep, voffA);
        if (wr == 1) PG8_BAR;
        PG8_WAIT_V(4); PG8_BAR;
        PG8_STAGE(PG8_SB(1, 0), cB + kstep, voffB); PG8_STAGE(PG8_SA(1, 0), cA + kstep, voffA); PG8_STAGE(PG8_SB(1, 1), cB + hstep + kstep, voffB);
        PG8_WAIT_V(6); PG8_BAR;
    }
    for (;;) {
        const bool has_next = S.next(ui + 1, nxt);
        const char* nA = has_next ? (const char*)g.A + (size_t)nxt.pm * tstep : cA; const char* nB = has_next ? (const char*)g.Bt + (size_t)nxt.pn * tstep : cB;
        for (int t = 0; t < nt; t += 2) {
            const bool last = (t == nt - 2);
            const char* a1 = cA + (size_t)(t + 1) * kstep;
            const char* a2 = last ? nA : cA + (size_t)(t + 2) * kstep; const char* b2 = last ? nB : cB + (size_t)(t + 2) * kstep;
            const char* a3 = a2 + kstep; const char* b3 = b2 + kstep;
            if (last && has_next) S.a_ready(nxt);
            if constexpr (SP2) {
            PG8_LDB(B0, 0, 0); PG8_LDB(B1, 0, 1); PG8_SCHED; PG8_LDA(At, 0, 0); PG8_STAGE(PG8_SA(1, 1), a1 + hstep, voffA);
            PG8_WAIT_V(8); PG8_WAIT_L(0); PG8_BAR; PG8_MMA(0, 0, At, B0); PG8_MMA(0, 1, At, B1); PG8_BAR; PG8_SCHED;
            PG8_LDA(At, 0, 1); PG8_STAGE(PG8_SB(0, 0), b2, voffB); PG8_STAGE(PG8_SB(0, 1), b2 + hstep, voffB); PG8_STAGE(PG8_SA(0, 0), a2, voffA);
            PG8_WAIT_V(8); PG8_WAIT_L(0); PG8_BAR; PG8_MMA(1, 0, At, B0); PG8_MMA(1, 1, At, B1); PG8_BAR; PG8_SCHED;
            PG8_LDB(B0, 1, 0); PG8_LDB(B1, 1, 1); PG8_SCHED; PG8_LDA(At, 1, 0); PG8_STAGE(PG8_SA(0, 1), a2 + hstep, voffA);
            PG8_WAIT_V(8); PG8_WAIT_L(0); PG8_BAR; PG8_MMA(0, 0, At, B0); PG8_MMA(0, 1, At, B1); PG8_BAR; PG8_SCHED;
            PG8_LDA(At, 1, 1); PG8_STAGE(PG8_SB(1, 0), b3, voffB); PG8_STAGE(PG8_SB(1, 1), b3 + hstep, voffB); PG8_STAGE(PG8_SA(1, 0), a3, voffA);
            PG8_WAIT_V(8); PG8_WAIT_L(0); PG8_BAR; PG8_MMA(1, 0, At, B0); PG8_MMA(1, 1, At, B1); PG8_BAR; PG8_SCHED;
            } else {
            PG8_LDB(B0, 0, 0); PG8_SCHED; PG8_LDA(At, 0, 0); PG8_STAGE(PG8_SA(1, 1), a1 + hstep, voffA);
            PG8_WAIT_L(8); PG8_BAR; PG8_WAIT_L(0); PG8_MMA(0, 0, At, B0); PG8_BAR; PG8_SCHED;
            PG8_LDB(B1, 0, 1); PG8_STAGE(PG8_SB(0, 0), b2, voffB);
            PG8_BAR; PG8_WAIT_L(0); PG8_MMA(0, 1, At, B1); PG8_BAR;
            PG8_LDA(At, 0, 1); PG8_STAGE(PG8_SA(0, 0), a2, voffA);
            PG8_BAR; PG8_WAIT_L(0); PG8_MMA(1, 0, At, B0); PG8_BAR; PG8_SCHED;
            PG8_STAGE(PG8_SB(0, 1), b2 + hstep, voffB);
            PG8_WAIT_V(6); PG8_BAR; PG8_MMA(1, 1, At, B1); PG8_BAR;
            PG8_LDB(B0, 1, 0); PG8_SCHED; PG8_LDA(At, 1, 0); PG8_STAGE(PG8_SA(0, 1), a2 + hstep, voffA);
            PG8_WAIT_L(8); PG8_BAR; PG8_WAIT_L(0); PG8_MMA(0, 0, At, B0); PG8_BAR; PG8_SCHED;
            PG8_LDB(B1, 1, 1); PG8_STAGE(PG8_SB(1, 0), b3, voffB);
            PG8_BAR; PG8_WAIT_L(0); PG8_MMA(0, 1, At, B1); PG8_BAR;
            PG8_LDA(At, 1, 1); PG8_STAGE(PG8_SA(1, 0), a3, voffA);
            PG8_BAR; PG8_WAIT_L(0); PG8_MMA(1, 0, At, B0); PG8_BAR; PG8_SCHED;
            PG8_STAGE(PG8_SB(1, 1), b3 + hstep, voffB);
            PG8_WAIT_V(6); PG8_BAR; PG8_MMA(1, 1, At, B1); PG8_BAR;
            }
        }
        if constexpr (ALIGN_EPI) { if (wr == 0) PG8_BAR; }
        if constexpr (!Epi::AFTER_DRAIN) { E(acc, cur, wr, wc, fr, fq); S.done(cur); }
        if (!has_next) break;
#pragma unroll
        for (int a = 0; a < 2; ++a)
#pragma unroll
            for (int b = 0; b < 2; ++b)
#pragma unroll
                for (int m = 0; m < 4; ++m)
#pragma unroll
                    for (int n = 0; n < 2; ++n) acc[a][b][m][n] = (f32x4){0.f, 0.f, 0.f, 0.f};
        cur = nxt; cA = nA; cB = nB; ++ui;
        if constexpr (ALIGN_EPI) { if (wr == 1) PG8_BAR; }
    }
    PG8_WAIT_V(0);
    if constexpr (!ALIGN_EPI) { if (wr == 0) PG8_BAR; }
    PG8_BAR;
    if constexpr (Epi::AFTER_DRAIN) { E.fused(acc, cur, wr, wc, fr, fq, lds, wid, lane); S.done(cur); }
#undef PG8_SA
#undef PG8_SB
#undef PG8_STAGE
#undef PG8_LDA
#undef PG8_LDB
#undef PG8_MMA
#undef PG8_WAIT_V
#undef PG8_WAIT_L
#undef PG8_BAR
#undef PG8_SCHED
}
}

namespace pg8 {
struct EpiRes {
    static constexpr bool PERM = false, AFTER_DRAIN = false;
    float* io; int ldc; float alpha;
    __device__ __forceinline__ void operator()(const f32x4 (&acc)[2][2][4][2], const Unit& u, int wr, int wc, int fr, int fq) const {
        const int col0 = u.pn * BM + wc * 32 + 4 * fq;
#pragma unroll
        for (int ai = 0; ai < 2; ++ai)
#pragma unroll
            for (int m = 0; m < 4; ++m) { float* rp = io + (size_t)(u.pm * BM + ai * HALF + wr * 64 + m * 16 + fr) * ldc + col0;
#pragma unroll
                for (int bj = 0; bj < 2; ++bj)
#pragma unroll
                    for (int n = 0; n < 2; ++n) { f32x4* p = (f32x4*)(rp + bj * HALF + n * 16); const f32x4 o = *p; *p = o * alpha + acc[ai][bj][m][n]; } }
    }
};
}

constexpr int BATCH = 4, SEQ = 4096, DM = 1024, DEPTH = 2, HD = 64, GW = 256, NH = 4, DIN = 3328, DFF = 4096, M = BATCH * SEQ;
constexpr float LN_EPS = 1e-5f, NORM_EPS = 1e-6f;
constexpr float ALPHA = 1.41421356237309515f;
constexpr int NCH = SEQ / 128;
constexpr int NITEM = BATCH * NH * NCH;

constexpr size_t MiB = 1u << 20;
constexpr size_t W_IN_B = (size_t)DIN * DM * 2, W_OUT_B = (size_t)DM * DM * 2, W_UP_B = (size_t)DFF * DM * 2, W_DN_B = (size_t)DM * DFF * 2;
constexpr size_t W_LAYER_B = W_IN_B + W_OUT_B + W_UP_B + W_DN_B;
constexpr size_t WS_W = 0;
constexpr size_t WS_XN = 52 * MiB;
constexpr size_t WS_PROJ = 84 * MiB;
constexpr size_t WS_Y = 188 * MiB;
constexpr size_t WS_U = 84 * MiB;
constexpr size_t WS_KVB = 220 * MiB;
constexpr size_t WS_KVD = 228 * MiB;
constexpr size_t WS_DVEC = 236 * MiB;
constexpr size_t WS_ASUM = 236 * MiB + 256 * 1024;
constexpr size_t WS_LB = 236 * MiB + 768 * 1024;
constexpr size_t WS_ROPE = 237 * MiB;
constexpr size_t WS_END = 238 * MiB;
static_assert(2 * W_LAYER_B <= WS_XN, "weights fit");

constexpr int LDS_BYTES = 147456;

typedef unsigned short bf16;
typedef unsigned v4u __attribute__((ext_vector_type(4)));
typedef unsigned v2u __attribute__((ext_vector_type(2)));
typedef float f32x4 __attribute__((ext_vector_type(4)));
typedef short bf16x8 __attribute__((ext_vector_type(8)));
#define LAS __attribute__((address_space(3)))
#define MFMA16(a, b, c) __builtin_amdgcn_mfma_f32_16x16x32_bf16((a), (b), (c), 0, 0, 0)

typedef float f32x2_ __attribute__((ext_vector_type(2)));
typedef __bf16 bf16x2_ __attribute__((ext_vector_type(2)));
__device__ __forceinline__ unsigned pk2(float lo, float hi) { f32x2_ v = {lo, hi}; bf16x2_ b = __builtin_convertvector(v, bf16x2_); return __builtin_bit_cast(unsigned, b); }
__device__ __forceinline__ float bflo(unsigned u) { return __uint_as_float(u << 16); }
__device__ __forceinline__ float bfhi(unsigned u) { return __uint_as_float(u & 0xffff0000u); }
__device__ __forceinline__ float bf1(bf16 u) { return __uint_as_float(((unsigned)u) << 16); }
__device__ __forceinline__ bf16 f2bf(float f) { return (bf16)(pk2(f, 0.f) & 0xffffu); }
__device__ __forceinline__ bf16x8 pack8(const float (&v)[8]) {
    v4u w; w.x = pk2(v[0], v[1]); w.y = pk2(v[2], v[3]); w.z = pk2(v[4], v[5]); w.w = pk2(v[6], v[7]);
    return __builtin_bit_cast(bf16x8, w);
}
__device__ __forceinline__ void unpack8(v4u w, float (&v)[8]) {
    v[0] = bflo(w.x); v[1] = bfhi(w.x); v[2] = bflo(w.y); v[3] = bfhi(w.y); v[4] = bflo(w.z); v[5] = bfhi(w.z); v[6] = bflo(w.w); v[7] = bfhi(w.w);
}
__device__ __forceinline__ float wave_sum(float v) {
#pragma unroll
    for (int o = 1; o < 64; o <<= 1) v += __shfl_xor(v, o);
    return v;
}
__device__ __forceinline__ float sigmoidf_(float x) { return __builtin_amdgcn_rcpf(1.f + __expf(-x)); }
__device__ __forceinline__ float siluf_(float x) { return x * sigmoidf_(x); }
__device__ __forceinline__ float gelu_tanh_(float x) { const float u = 0.7978845608028654f * (x + 0.044715f * x * x * x); const float t = 1.f - 2.f * __builtin_amdgcn_rcpf(1.f + __expf(2.f * u)); return 0.5f * x * (1.f + t); }
__device__ __forceinline__ float softplusf_(float z) { return fmaxf(z, 0.f) + __logf(1.f + __expf(-fabsf(z))); }

struct Params {
    const float* in[21];
    float* out;
    unsigned char* ws;
};

__device__ __forceinline__ void p0_transpose_item(const float* W, int K, int N, bf16* WT, float* scr, int item, int lane) {
    const int nblk = N / 32, kb = item / nblk, nb = item % nblk, k0 = 64 * kb, n0 = 32 * nb;
#pragma unroll 8
    for (int i = 0; i < 32; ++i) { const int kk = 2 * i + (lane >> 5); scr[kk * 33 + (lane & 31)] = W[(size_t)(k0 + kk) * N + n0 + (lane & 31)]; }
    asm volatile("s_waitcnt lgkmcnt(0)" ::: "memory");
    const int c = lane & 7;
#pragma unroll
    for (int j = 0; j < 4; ++j) { const int n = (lane >> 3) + 8 * j; const float* s = scr + (8 * c) * 33 + n;
        v4u o; o.x = pk2(s[0 * 33], s[1 * 33]); o.y = pk2(s[2 * 33], s[3 * 33]); o.z = pk2(s[4 * 33], s[5 * 33]); o.w = pk2(s[6 * 33], s[7 * 33]);
        *(v4u*)(WT + (size_t)(n0 + n) * K + k0 + 8 * c) = o; }
    asm volatile("s_waitcnt lgkmcnt(0)" ::: "memory");
}
__device__ __forceinline__ void ln_row(const float* src, const float* g, const float* b, float* dstf, bf16* dstb, int lane) {
    const f32x4* xr = (const f32x4*)src + lane;
    f32x4 v[4]; float s = 0.f;
#pragma unroll
    for (int j = 0; j < 4; ++j) { v[j] = xr[64 * j]; s += (v[j].x + v[j].y) + (v[j].z + v[j].w); }
    const float mean = wave_sum(s) * (1.f / DM); float s2 = 0.f;
#pragma unroll
    for (int j = 0; j < 4; ++j) { v[j] = v[j] - mean; s2 += (v[j].x * v[j].x + v[j].y * v[j].y) + (v[j].z * v[j].z + v[j].w * v[j].w); }
    const float rstd = 1.f / sqrtf(wave_sum(s2) * (1.f / DM) + LN_EPS);
#pragma unroll
    for (int j = 0; j < 4; ++j) {
        const f32x4 gg = ((const f32x4*)g)[lane + 64 * j], bb = ((const f32x4*)b)[lane + 64 * j];
        const f32x4 o = v[j] * rstd * gg + bb;
        ((f32x4*)dstf)[lane + 64 * j] = o;
        v2u w; w.x = pk2(o.x, o.y); w.y = pk2(o.z, o.w);
        ((v2u*)dstb)[lane + 64 * j] = w;
    }
}
__device__ __forceinline__ void ln_phase(const float* g, const float* b, float* io, bf16* xn, int gw, int ngw, int lane) {
    for (int m = gw; m < M; m += ngw) ln_row(io + (size_t)m * DM, g, b, io + (size_t)m * DM, xn + (size_t)m * DM, lane);
}

__device__ __forceinline__ void prologue(const Params& p, unsigned char* lds, int tid) {
    const int lane = tid & 63, wave = tid >> 6;
    const int gw = blockIdx.x * 8 + wave, ngw = gridDim.x * 8;
    float* scr = (float*)(lds + wave * 16384);
    constexpr int I_IN = (DM / 64) * (DIN / 32), I_OUT = (DM / 64) * (DM / 32), I_UP = (DM / 64) * (DFF / 32), I_DN = (DFF / 64) * (DM / 32);
    constexpr int I_L = I_IN + I_OUT + I_UP + I_DN;
    for (int it = gw; it < DEPTH * I_L; it += ngw) {
        const int l = it / I_L; int r = it % I_L;
        bf16* wb = (bf16*)(p.ws + WS_W + (size_t)l * W_LAYER_B);
        if (r < I_IN) { p0_transpose_item(p.in[3] + (size_t)l * DM * DIN, DM, DIN, wb, scr, r, lane); continue; } r -= I_IN;
        if (r < I_OUT) { p0_transpose_item(p.in[14] + (size_t)l * DM * DM, DM, DM, wb + (size_t)DIN * DM, scr, r, lane); continue; } r -= I_OUT;
        if (r < I_UP) { p0_transpose_item(p.in[17] + (size_t)l * DM * DFF, DM, DFF, wb + (size_t)DIN * DM + (size_t)DM * DM, scr, r, lane); continue; } r -= I_UP;
        p0_transpose_item(p.in[18] + (size_t)l * DFF * DM, DFF, DM, wb + (size_t)DIN * DM + (size_t)DM * DM + (size_t)DFF * DM, scr, r, lane);
    }
    for (int m = gw; m < M; m += ngw) ln_row(p.in[0] + (size_t)m * DM, p.in[1], p.in[2], p.out + (size_t)m * DM, (bf16*)(p.ws + WS_XN) + (size_t)m * DM, lane);
#if defined(MK_ZERO_DIAG)
    { v4u* z = (v4u*)(p.ws + WS_Y); const size_t n = (WS_LB - WS_Y) / 16; for (size_t i = (size_t)blockIdx.x * 512 + tid; i < n; i += (size_t)gridDim.x * 512) z[i] = (v4u){0u, 0u, 0u, 0u}; }
#endif
    {
        float* rc = (float*)(p.ws + WS_ROPE); float* rs = rc + SEQ * 32;
        for (int i = blockIdx.x * 512 + tid; i < SEQ * 32; i += gridDim.x * 512) {
            const int pos = i >> 5, f = i & 31;
            const float inv = powf(10000.f, -(float)(2 * f) / 64.f);
            const float ang = (float)pos * inv;
            const float n = rintf(ang * 0.15915494309189535f);
            float r = fmaf(-n, 6.2831854820251465f, ang); r = fmaf(-n, -1.7484555e-7f, r);
            rc[i] = __cosf(r); rs[i] = __sinf(r);
        }
    }
    if (blockIdx.x == 0 && tid < GW) {
        const float* lg = p.in[12]; float* lb = (float*)(p.ws + WS_LB);
        float mx = lg[tid]; for (int l = 1; l < DEPTH; ++l) mx = fmaxf(mx, lg[l * GW + tid]);
        float den = 0.f; for (int l = 0; l < DEPTH; ++l) den += expf(lg[l * GW + tid] - mx);
        const float p0 = expf(lg[tid] - mx) / den; float cum = 0.f;
        for (int l = 0; l < DEPTH; ++l) { cum += expf(lg[l * GW + tid] - mx) / den; lb[l * GW + tid] = cum - p0; }
    }
}

constexpr int L_KS = 0;
constexpr int L_VT = 18432;
constexpr int L_ST = 35840;
constexpr int L_BS = 45056;
constexpr int L_KF = 79872;
constexpr int L_TOT = 114688;
constexpr int L_FLAG = 120000;
constexpr int L_WAT = 18432, L_WXT = 27648, L_AS = 36864, L_US = 71680, L_SEGA = 106496, L_SEGH = 108544;

__device__ __forceinline__ void stage_vt(bf16* Vt, const bf16* Vg, int tid) {
    const int s = tid & 127, eg = tid >> 7;
    const bf16* src = Vg + (size_t)s * DIN + 16 * eg;
    const v4u a = *(const v4u*)src, c = *(const v4u*)(src + 8);
    bf16* vt = Vt + (16 * eg) * 136 + s;
    vt[0 * 136] = (bf16)(a.x & 0xffffu); vt[1 * 136] = (bf16)(a.x >> 16); vt[2 * 136] = (bf16)(a.y & 0xffffu); vt[3 * 136] = (bf16)(a.y >> 16);
    vt[4 * 136] = (bf16)(a.z & 0xffffu); vt[5 * 136] = (bf16)(a.z >> 16); vt[6 * 136] = (bf16)(a.w & 0xffffu); vt[7 * 136] = (bf16)(a.w >> 16);
    vt[8 * 136] = (bf16)(c.x & 0xffffu); vt[9 * 136] = (bf16)(c.x >> 16); vt[10 * 136] = (bf16)(c.y & 0xffffu); vt[11 * 136] = (bf16)(c.y >> 16);
    vt[12 * 136] = (bf16)(c.z & 0xffffu); vt[13 * 136] = (bf16)(c.z >> 16); vt[14 * 136] = (bf16)(c.w & 0xffffu); vt[15 * 136] = (bf16)(c.w >> 16);
}
__device__ __forceinline__ bf16x8 vt_frag2(const bf16* Vt, int e, int lo, int hi, int q4) {
    const v2u a = *(const v2u*)(Vt + e * 136 + 16 * lo + 4 * q4), c = *(const v2u*)(Vt + e * 136 + 16 * hi + 4 * q4);
    v4u w; w.x = a.x; w.y = a.y; w.z = c.x; w.w = c.y; return __builtin_bit_cast(bf16x8, w);
}
__device__ __forceinline__ void kv_product(const bf16* Kt, const bf16* Vt, float* out, int w, int c16, int q4) {
    const int dt = w >> 1, et0 = 2 * (w & 1);
    f32x4 acc[2] = {{0.f, 0.f, 0.f, 0.f}, {0.f, 0.f, 0.f, 0.f}};
#pragma unroll
    for (int ks = 0; ks < 4; ++ks) {
        const bf16x8 a = *(const bf16x8*)(Kt + (16 * dt + c16) * 136 + 32 * ks + 8 * q4);
#pragma unroll
        for (int e2 = 0; e2 < 2; ++e2) { const bf16x8 b = *(const bf16x8*)(Vt + (16 * (et0 + e2) + c16) * 136 + 32 * ks + 8 * q4); acc[e2] = MFMA16(a, b, acc[e2]); }
    }
#pragma unroll
    for (int e2 = 0; e2 < 2; ++e2)
#pragma unroll
        for (int r = 0; r < 4; ++r) out[(16 * dt + 4 * q4 + r) * 64 + 16 * (et0 + e2) + c16] = acc[e2][r];
}

__device__ __forceinline__ void c_tile(const bf16* Ks, const bf16x8 (&Qf)[2], int j, int sbase, int tq, int lane, int c16, int q4, float& R, float (&wv)[4]) {
    const bf16x8 k0 = *(const bf16x8*)(Ks + (16 * j + c16) * 72 + 8 * q4), k1 = *(const bf16x8*)(Ks + (16 * j + c16) * 72 + 32 + 8 * q4);
    f32x4 z = {0.f, 0.f, 0.f, 0.f};
    z = MFMA16(k0, Qf[0], z); z = MFMA16(k1, Qf[1], z);
    float lk[4], ls[4]; bool valid[4];
#pragma unroll
    for (int r = 0; r < 4; ++r) { const float zz = z[r] * 0.125f; valid[r] = (sbase + 16 * j + 4 * q4 + r) < tq; const float sp = softplusf_(zz); lk[r] = valid[r] ? -sp : 0.f; ls[r] = zz - sp; }
    const float suf2 = lk[3], suf1 = suf2 + lk[2], suf0 = suf1 + lk[1], T = suf0 + lk[0];
    const float t1 = __shfl(T, (lane + 16) & 63), t2 = __shfl(T, (lane + 32) & 63), t3 = __shfl(T, (lane + 48) & 63);
    const float X = (q4 < 3 ? t1 : 0.f) + (q4 < 2 ? t2 : 0.f) + (q4 < 1 ? t3 : 0.f);
    float tot = T + __shfl_xor(T, 16); tot += __shfl_xor(tot, 32);
    const float base = R + X;
    wv[0] = valid[0] ? __expf(ls[0] + base + suf0) : 0.f;
    wv[1] = valid[1] ? __expf(ls[1] + base + suf1) : 0.f;
    wv[2] = valid[2] ? __expf(ls[2] + base + suf2) : 0.f;
    wv[3] = valid[3] ? __expf(ls[3] + base) : 0.f;
    R += tot;
}
__device__ __forceinline__ void mixer_c_item(unsigned char* lds, const bf16* proj, bf16* Y, int item, int tid_in) {
    int tid = tid_in; asm volatile("" : "+v"(tid));
    const int lane = tid & 63, w = __builtin_amdgcn_readfirstlane(tid >> 6), c16 = lane & 15, q4 = lane >> 4;
    const int qb = 31 - (item & 31), bh = item >> 5, b = bh >> 2, h = bh & 3;
    const size_t row0 = (size_t)b * SEQ;
    const bf16* Qg = proj + 6 * GW + h * HD; const bf16* Kg = proj + 7 * GW + h * HD; const bf16* Vg = proj + 8 * GW + h * HD;
    bf16* Ks = (bf16*)(lds + L_KS); bf16* Vt = (bf16*)(lds + L_VT); volatile unsigned* flags = (volatile unsigned*)(lds + L_FLAG);
    const int tq = qb * 128 + 16 * w + c16;
    bf16x8 Qf[2];
    Qf[0] = *(const bf16x8*)(Qg + (row0 + tq) * DIN + 8 * q4); Qf[1] = *(const bf16x8*)(Qg + (row0 + tq) * DIN + 32 + 8 * q4);
    f32x4 accO[4];
#pragma unroll
    for (int et = 0; et < 4; ++et) accO[et] = (f32x4){0.f, 0.f, 0.f, 0.f};
    float R = 0.f; bool done = false;
    __syncthreads();
    for (int kb = qb; kb >= 0; --kb) {
        { const int s = tid >> 2, part = tid & 3; const bf16* src = Kg + (row0 + kb * 128 + s) * DIN + 16 * part;
          const v4u a = *(const v4u*)src, c = *(const v4u*)(src + 8); *(v4u*)(Ks + s * 72 + 16 * part) = a; *(v4u*)(Ks + s * 72 + 16 * part + 8) = c; }
        stage_vt(Vt, Vg + (row0 + kb * 128) * DIN, tid);
        __syncthreads();
        if (!done) {
            const int ptop = (kb == qb) ? (w >> 1) : 3;
            for (int pp = ptop; pp >= 0; --pp) {
                float wh[4], wl[4];
                c_tile(Ks, Qf, 2 * pp + 1, kb * 128, tq, lane, c16, q4, R, wh);
                c_tile(Ks, Qf, 2 * pp, kb * 128, tq, lane, c16, q4, R, wl);
                const float pv[8] = {wl[0], wl[1], wl[2], wl[3], wh[0], wh[1], wh[2], wh[3]};
                const bf16x8 P = pack8(pv);
#pragma unroll
                for (int et = 0; et < 4; ++et) accO[et] = MFMA16(vt_frag2(Vt, 16 * et + c16, 2 * pp, 2 * pp + 1, q4), P, accO[et]);
                if (__all(R < -104.f)) { done = true; break; }
            }
        }
        if (lane == 0) flags[w] = done ? 1u : 0u;
        __syncthreads();
        unsigned alld = 1u;
#pragma unroll
        for (int i = 0; i < 8; ++i) alld &= flags[i];
        if (alld) break;
    }
    bf16* yp = Y + (row0 + tq) * DM + 2 * GW + h * HD + 4 * q4;
#pragma unroll
    for (int et = 0; et < 4; ++et) { v2u o; o.x = pk2(accO[et][0], accO[et][1]); o.y = pk2(accO[et][2], accO[et][3]); *(v2u*)(yp + 16 * et) = o; }
}

__device__ __forceinline__ void rope8(const bf16* src, const float* rc, const float* rs, int pos, int part, float (&r1)[8], float (&r2)[8]) {
    float x1[8], x2[8];
    unpack8(*(const v4u*)(src + 8 * part), x1); unpack8(*(const v4u*)(src + 32 + 8 * part), x2);
    const f32x4 c0 = *(const f32x4*)(rc + pos * 32 + 8 * part), c1 = *(const f32x4*)(rc + pos * 32 + 8 * part + 4);
    const f32x4 s0 = *(const f32x4*)(rs + pos * 32 + 8 * part), s1 = *(const f32x4*)(rs + pos * 32 + 8 * part + 4);
    const float cc[8] = {c0.x, c0.y, c0.z, c0.w, c1.x, c1.y, c1.z, c1.w}, ss[8] = {s0.x, s0.y, s0.z, s0.w, s1.x, s1.y, s1.z, s1.w};
#pragma unroll
    for (int i = 0; i < 8; ++i) { r1[i] = x1[i] * cc[i] - x2[i] * ss[i]; r2[i] = x1[i] * ss[i] + x2[i] * cc[i]; }
}
__device__ __forceinline__ void mixer_b_pass1(unsigned char* lds, const Params& p, const bf16* proj, int item, int tid_in) {
    int tid = tid_in; asm volatile("" : "+v"(tid));
    const int lane = tid & 63, w = __builtin_amdgcn_readfirstlane(tid >> 6), c16 = lane & 15, q4 = lane >> 4;
    const int c = item & 31, bh = item >> 5, b = bh >> 2, h = bh & 3;
    const size_t row0 = (size_t)b * SEQ;
    const float* rc = (const float*)(p.ws + WS_ROPE); const float* rs = rc + SEQ * 32;
    bf16* Kt = (bf16*)(lds + L_KS); bf16* Vt = (bf16*)(lds + L_VT);
    const float lg2 = log2f(1.f - exp2f(-5.f - (float)h));
    __syncthreads();
    {
        const int s = tid & 127, part = tid >> 7, pos = c * 128 + s;
        float r1[8], r2[8];
        rope8(proj + (row0 + pos) * DIN + 3 * GW + h * HD, rc, rs, pos, part, r1, r2);
        const float sc = 0.125f * exp2f(lg2 * (float)(127 - s));
#pragma unroll
        for (int i = 0; i < 8; ++i) { Kt[(8 * part + i) * 136 + s] = f2bf(r1[i] * sc); Kt[(32 + 8 * part + i) * 136 + s] = f2bf(r2[i] * sc); }
    }
    stage_vt(Vt, proj + (row0 + c * 128) * DIN + 4 * GW + h * HD, tid);
    __syncthreads();
    kv_product(Kt, Vt, (float*)(p.ws + WS_KVB) + (size_t)item * 4096, w, c16, q4);
}
__device__ __forceinline__ void mixer_b_pass2(unsigned char* lds, const Params& p, const bf16* proj, bf16* Y, int l, int item, int tid_in) {
    int tid = tid_in; asm volatile("" : "+v"(tid));
    const int lane = tid & 63, w = __builtin_amdgcn_readfirstlane(tid >> 6), c16 = lane & 15, q4 = lane >> 4;
    const int c = item & 31, bh = item >> 5, b = bh >> 2, h = bh & 3;
    const size_t row0 = (size_t)b * SEQ;
    const float* rc = (const float*)(p.ws + WS_ROPE); const float* rs = rc + SEQ * 32;
    bf16* Ks = (bf16*)(lds + L_KS); bf16* Vt = (bf16*)(lds + L_VT); bf16* St = (bf16*)(lds + L_ST);
    const float lg2 = log2f(1.f - exp2f(-5.f - (float)h));
    __syncthreads();
    {
        const int e = tid & 63, dg = tid >> 6; const float Gam = exp2f(lg2 * 128.f);
        float S[8];
#pragma unroll
        for (int i = 0; i < 8; ++i) S[i] = 0.f;
        const float* kv = (const float*)(p.ws + WS_KVB) + (size_t)(bh * 32) * 4096 + (8 * dg) * 64 + e;
        for (int j = 0; j < c; ++j) {
#pragma unroll
            for (int i = 0; i < 8; ++i) S[i] = Gam * S[i] + kv[(size_t)j * 4096 + i * 64];
        }
        *(bf16x8*)(St + e * 72 + 8 * dg) = pack8(S);
    }
    {
        const int s = tid >> 2, part = tid & 3, pos = c * 128 + s;
        float r1[8], r2[8];
        rope8(proj + (row0 + pos) * DIN + 3 * GW + h * HD, rc, rs, pos, part, r1, r2);
#pragma unroll
        for (int i = 0; i < 8; ++i) { r1[i] *= 0.125f; r2[i] *= 0.125f; }
        *(bf16x8*)(Ks + s * 72 + 8 * part) = pack8(r1); *(bf16x8*)(Ks + s * 72 + 32 + 8 * part) = pack8(r2);
    }
    stage_vt(Vt, proj + (row0 + c * 128) * DIN + 4 * GW + h * HD, tid);
    __syncthreads();
    const int tl = 16 * w + c16, pos = c * 128 + tl;
    bf16x8 Qf[2];
    { float r1[8], r2[8]; rope8(proj + (row0 + pos) * DIN + 2 * GW + h * HD, rc, rs, pos, q4, r1, r2); Qf[0] = pack8(r1); Qf[1] = pack8(r2); }
    f32x4 accO[4];
    const float qd = exp2f(lg2 * (float)(tl + 1));
#pragma unroll
    for (int et = 0; et < 4; ++et) {
        f32x4 a = {0.f, 0.f, 0.f, 0.f};
        a = MFMA16(*(const bf16x8*)(St + (16 * et + c16) * 72 + 8 * q4), Qf[0], a);
        a = MFMA16(*(const bf16x8*)(St + (16 * et + c16) * 72 + 32 + 8 * q4), Qf[1], a);
        accO[et] = a * qd;
    }
    for (int pp = (w >> 1); pp >= 0; --pp) {
        float pv[8];
#pragma unroll
        for (int hh = 0; hh < 2; ++hh) {
            const int j = 2 * pp + hh;
            f32x4 z = {0.f, 0.f, 0.f, 0.f};
            z = MFMA16(*(const bf16x8*)(Ks + (16 * j + c16) * 72 + 8 * q4), Qf[0], z);
            z = MFMA16(*(const bf16x8*)(Ks + (16 * j + c16) * 72 + 32 + 8 * q4), Qf[1], z);
#pragma unroll
            for (int r = 0; r < 4; ++r) { const int df = tl - (16 * j + 4 * q4 + r); pv[4 * hh + r] = (df >= 0) ? z[r] * exp2f(lg2 * (float)df) : 0.f; }
        }
        const bf16x8 P = pack8(pv);
#pragma unroll
        for (int et = 0; et < 4; ++et) accO[et] = MFMA16(vt_frag2(Vt, 16 * et + c16, 2 * pp, 2 * pp + 1, q4), P, accO[et]);
    }
    float s = 0.f;
#pragma unroll
    for (int et = 0; et < 4; ++et) s += (accO[et][0] + accO[et][1]) + (accO[et][2] + accO[et][3]);
    s += __shfl_xor(s, 16); s += __shfl_xor(s, 32);
    const float mu = s * (1.f / 64.f); float qv = 0.f;
#pragma unroll
    for (int et = 0; et < 4; ++et)
#pragma unroll
        for (int r = 0; r < 4; ++r) { const float d = accO[et][r] - mu; qv += d * d; }
    qv += __shfl_xor(qv, 16); qv += __shfl_xor(qv, 32);
    const float rstd = 1.f / sqrtf(qv * (1.f / 64.f) + NORM_EPS);
    const float* ng = p.in[11] + l * GW + h * HD + 4 * q4;
    const bf16* gp = proj + (row0 + pos) * DIN + 5 * GW + h * HD + 4 * q4;
    bf16* yp = Y + (row0 + pos) * DM + 1 * GW + h * HD + 4 * q4;
#pragma unroll
    for (int et = 0; et < 4; ++et) {
        const f32x4 g4 = *(const f32x4*)(ng + 16 * et); const v2u gg = *(const v2u*)(gp + 16 * et);
        const float o0 = (accO[et][0] - mu) * rstd * g4.x * siluf_(bflo(gg.x)), o1 = (accO[et][1] - mu) * rstd * g4.y * siluf_(bfhi(gg.x));
        const float o2 = (accO[et][2] - mu) * rstd * g4.z * siluf_(bflo(gg.y)), o3 = (accO[et][3] - mu) * rstd * g4.w * siluf_(bfhi(gg.y));
        v2u o; o.x = pk2(o0, o1); o.y = pk2(o2, o3); *(v2u*)(yp + 16 * et) = o;
    }
}

__device__ __forceinline__ void d_gates(unsigned char* lds, const Params& p, const bf16* proj, int l, int bh, int c, int tid, float (&bl)[16], float (&kk)[16], float& bend) {
    const int ch = tid & 63, blk = tid >> 6, b = bh >> 2, h = bh & 3;
    const size_t row0 = (size_t)b * SEQ;
    float* tot = (float*)(lds + L_TOT);
    const float lb = ((const float*)(p.ws + WS_LB))[l * GW + h * HD + ch];
    const bf16* fp = proj + (row0 + c * 128 + 16 * blk) * DIN + 10 * GW + h * HD + ch;
    float run = 0.f;
#pragma unroll
    for (int i = 0; i < 16; ++i) {
        float x = bf1(fp[(size_t)i * DIN]); x = fminf(fmaxf(x, -80.f), 80.f);
        const float ex = __expf(-x), sg = __builtin_amdgcn_rcpf(1.f + ex);
        const float f = lb + (1.f - lb) * sg;
        run += __logf(fmaxf(f, 1e-30f));
        bl[i] = run; kk[i] = (1.f - lb) * (ex * sg);
    }
    tot[blk * 64 + ch] = run;
    __syncthreads();
    float pre = 0.f, all = 0.f;
#pragma unroll
    for (int s = 0; s < 8; ++s) { const float t = tot[s * 64 + ch]; all += t; pre += (s < blk) ? t : 0.f; }
#pragma unroll
    for (int i = 0; i < 16; ++i) bl[i] += pre;
    bend = all;
}
__device__ __forceinline__ void mixer_d_pass1(unsigned char* lds, const Params& p, const bf16* proj, int l, int item, int tid_in) {
    int tid = tid_in; asm volatile("" : "+v"(tid));
    const int lane = tid & 63, w = __builtin_amdgcn_readfirstlane(tid >> 6), c16 = lane & 15, q4 = lane >> 4;
    const int c = item & 31, bh = item >> 5, b = bh >> 2, h = bh & 3;
    const size_t row0 = (size_t)b * SEQ;
    bf16* Kt = (bf16*)(lds + L_KS); bf16* Vt = (bf16*)(lds + L_VT);
    __syncthreads();
    float bl[16], kk[16], bend;
    d_gates(lds, p, proj, l, bh, c, tid, bl, kk, bend);
    {
        const int ch = tid & 63, blk = tid >> 6;
        float k0[8], k1[8];
#pragma unroll
        for (int i = 0; i < 8; ++i) { k0[i] = kk[i] * __expf(bend - bl[i]); k1[i] = kk[8 + i] * __expf(bend - bl[8 + i]); }
        *(bf16x8*)(Kt + ch * 136 + 16 * blk) = pack8(k0); *(bf16x8*)(Kt + ch * 136 + 16 * blk + 8) = pack8(k1);
        if (blk == 0) ((float*)(p.ws + WS_DVEC))[(size_t)item * 64 + ch] = __expf(bend);
    }
    stage_vt(Vt, proj + (row0 + c * 128) * DIN + 11 * GW + h * HD, tid);
    __syncthreads();
    kv_product(Kt, Vt, (float*)(p.ws + WS_KVD) + (size_t)item * 4096, w, c16, q4);
}
__device__ __forceinline__ void mixer_d_pass2(unsigned char* lds, const Params& p, const bf16* proj, bf16* Y, int l, int item, int tid_in) {
    int tid = tid_in; asm volatile("" : "+v"(tid));
    const int lane = tid & 63, w = __builtin_amdgcn_readfirstlane(tid >> 6), c16 = lane & 15, q4 = lane >> 4;
    const int c = item & 31, bh = item >> 5, b = bh >> 2, h = bh & 3;
    const size_t row0 = (size_t)b * SEQ;
    bf16* Vt = (bf16*)(lds + L_VT); bf16* St = (bf16*)(lds + L_ST); float* bS = (float*)(lds + L_BS); float* kS = (float*)(lds + L_KF);
    __syncthreads();
    {
        float bl[16], kk[16], bend;
        d_gates(lds, p, proj, l, bh, c, tid, bl, kk, bend);
        const int ch = tid & 63, blk = tid >> 6;
#pragma unroll
        for (int i = 0; i < 16; ++i) { bS[(16 * blk + i) * 68 + ch] = bl[i]; kS[(16 * blk + i) * 68 + ch] = kk[i]; }
    }
    {
        const int e = tid & 63, dg = tid >> 6;
        float S[8];
#pragma unroll
        for (int i = 0; i < 8; ++i) S[i] = 0.f;
        const float* kv = (const float*)(p.ws + WS_KVD) + (size_t)(bh * 32) * 4096 + (8 * dg) * 64 + e;
        const float* dv = (const float*)(p.ws + WS_DVEC) + (size_t)(bh * 32) * 64 + 8 * dg;
        for (int j = 0; j < c; ++j) {
#pragma unroll
            for (int i = 0; i < 8; ++i) S[i] = dv[j * 64 + i] * S[i] + kv[(size_t)j * 4096 + i * 64];
        }
        *(bf16x8*)(St + e * 72 + 8 * dg) = pack8(S);
    }
    stage_vt(Vt, proj + (row0 + c * 128) * DIN + 11 * GW + h * HD, tid);
    __syncthreads();
    const int tl = 16 * w + c16, pos = c * 128 + tl;
    float qv[16], bt[16], Bp[16];
    { const bf16* qp = proj + (row0 + pos) * DIN + 9 * GW + h * HD + 8 * q4; float a[8], bb[8]; unpack8(*(const v4u*)qp, a); unpack8(*(const v4u*)(qp + 32), bb);
#pragma unroll
      for (int i = 0; i < 8; ++i) { qv[i] = a[i]; qv[8 + i] = bb[i]; } }
#pragma unroll
    for (int ks = 0; ks < 2; ++ks) {
        const f32x4 b0 = *(const f32x4*)(bS + tl * 68 + 32 * ks + 8 * q4), b1 = *(const f32x4*)(bS + tl * 68 + 32 * ks + 8 * q4 + 4);
        bt[8 * ks + 0] = b0.x; bt[8 * ks + 1] = b0.y; bt[8 * ks + 2] = b0.z; bt[8 * ks + 3] = b0.w; bt[8 * ks + 4] = b1.x; bt[8 * ks + 5] = b1.y; bt[8 * ks + 6] = b1.z; bt[8 * ks + 7] = b1.w;
        if (w > 0) {
            const f32x4 p0 = *(const f32x4*)(bS + (16 * w - 1) * 68 + 32 * ks + 8 * q4), p1 = *(const f32x4*)(bS + (16 * w - 1) * 68 + 32 * ks + 8 * q4 + 4);
            Bp[8 * ks + 0] = p0.x; Bp[8 * ks + 1] = p0.y; Bp[8 * ks + 2] = p0.z; Bp[8 * ks + 3] = p0.w; Bp[8 * ks + 4] = p1.x; Bp[8 * ks + 5] = p1.y; Bp[8 * ks + 6] = p1.z; Bp[8 * ks + 7] = p1.w;
        } else {
#pragma unroll
            for (int i = 0; i < 8; ++i) Bp[8 * ks + i] = 0.f;
        }
    }
    bf16x8 Qh[2], Qt[2];
#pragma unroll
    for (int ks = 0; ks < 2; ++ks) {
        float a[8], t[8];
#pragma unroll
        for (int i = 0; i < 8; ++i) { a[i] = qv[8 * ks + i] * __expf(bt[8 * ks + i]); t[i] = qv[8 * ks + i] * __expf(bt[8 * ks + i] - Bp[8 * ks + i]); }
        Qh[ks] = pack8(a); Qt[ks] = pack8(t);
    }
    f32x4 accO[4];
#pragma unroll
    for (int et = 0; et < 4; ++et) {
        f32x4 a = {0.f, 0.f, 0.f, 0.f};
        a = MFMA16(*(const bf16x8*)(St + (16 * et + c16) * 72 + 8 * q4), Qh[0], a);
        a = MFMA16(*(const bf16x8*)(St + (16 * et + c16) * 72 + 32 + 8 * q4), Qh[1], a);
        accO[et] = a;
    }
    for (int pp = 0; 2 * pp < w; ++pp) {
        float pv[8];
#pragma unroll
        for (int hh = 0; hh < 2; ++hh) {
            const int j = 2 * pp + hh;
            if (j < w) {
                f32x4 z = {0.f, 0.f, 0.f, 0.f};
#pragma unroll
                for (int ks = 0; ks < 2; ++ks) {
                    const float* kr = kS + (16 * j + c16) * 68 + 32 * ks + 8 * q4; const float* br = bS + (16 * j + c16) * 68 + 32 * ks + 8 * q4;
                    const f32x4 k0 = *(const f32x4*)kr, k1 = *(const f32x4*)(kr + 4), b0 = *(const f32x4*)br, b1 = *(const f32x4*)(br + 4);
                    float kt[8];
                    kt[0] = k0.x * __expf(Bp[8 * ks + 0] - b0.x); kt[1] = k0.y * __expf(Bp[8 * ks + 1] - b0.y); kt[2] = k0.z * __expf(Bp[8 * ks + 2] - b0.z); kt[3] = k0.w * __expf(Bp[8 * ks + 3] - b0.w);
                    kt[4] = k1.x * __expf(Bp[8 * ks + 4] - b1.x); kt[5] = k1.y * __expf(Bp[8 * ks + 5] - b1.y); kt[6] = k1.z * __expf(Bp[8 * ks + 6] - b1.z); kt[7] = k1.w * __expf(Bp[8 * ks + 7] - b1.w);
                    z = MFMA16(pack8(kt), Qt[ks], z);
                }
#pragma unroll
                for (int r = 0; r < 4; ++r) pv[4 * hh + r] = z[r];
            } else {
#pragma unroll
                for (int r = 0; r < 4; ++r) pv[4 * hh + r] = 0.f;
            }
        }
        const bf16x8 P = pack8(pv);
#pragma unroll
        for (int et = 0; et < 4; ++et) accO[et] = MFMA16(vt_frag2(Vt, 16 * et + c16, 2 * pp, 2 * pp + 1, q4), P, accO[et]);
    }
    {
        float pd[8];
#pragma unroll
        for (int i = 0; i < 8; ++i) pd[i] = 0.f;
#pragma unroll
        for (int si = 0; si < 16; ++si) {
            const float* kr = kS + (16 * w + si) * 68 + 8 * q4; const float* br = bS + (16 * w + si) * 68 + 8 * q4;
            float v = 0.f;
#pragma unroll
            for (int ks = 0; ks < 2; ++ks) {
                const f32x4 k0 = *(const f32x4*)(kr + 32 * ks), k1 = *(const f32x4*)(kr + 32 * ks + 4), b0 = *(const f32x4*)(br + 32 * ks), b1 = *(const f32x4*)(br + 32 * ks + 4);
                v += qv[8 * ks + 0] * k0.x * __expf(fminf(bt[8 * ks + 0] - b0.x, 0.f)); v += qv[8 * ks + 1] * k0.y * __expf(fminf(bt[8 * ks + 1] - b0.y, 0.f));
                v += qv[8 * ks + 2] * k0.z * __expf(fminf(bt[8 * ks + 2] - b0.z, 0.f)); v += qv[8 * ks + 3] * k0.w * __expf(fminf(bt[8 * ks + 3] - b0.w, 0.f));
                v += qv[8 * ks + 4] * k1.x * __expf(fminf(bt[8 * ks + 4] - b1.x, 0.f)); v += qv[8 * ks + 5] * k1.y * __expf(fminf(bt[8 * ks + 5] - b1.y, 0.f));
                v += qv[8 * ks + 6] * k1.z * __expf(fminf(bt[8 * ks + 6] - b1.z, 0.f)); v += qv[8 * ks + 7] * k1.w * __expf(fminf(bt[8 * ks + 7] - b1.w, 0.f));
            }
            v += __shfl_xor(v, 16); v += __shfl_xor(v, 32);
            const float wv = (si <= c16) ? v : 0.f;
            if (q4 == (si >> 3)) pd[si & 7] = wv;
        }
        const bf16x8 P = pack8(pd);
        const bf16x8 zero8 = {0, 0, 0, 0, 0, 0, 0, 0};
#pragma unroll
        for (int et = 0; et < 4; ++et) {
            bf16x8 vf = zero8;
            if (q4 < 2) vf = *(const bf16x8*)(Vt + (16 * et + c16) * 136 + 16 * w + 8 * q4);
            accO[et] = MFMA16(vf, P, accO[et]);
        }
    }
    float ss = 0.f;
#pragma unroll
    for (int et = 0; et < 4; ++et)
#pragma unroll
        for (int r = 0; r < 4; ++r) ss += accO[et][r] * accO[et][r];
    ss += __shfl_xor(ss, 16); ss += __shfl_xor(ss, 32);
    const float rstd = 1.f / sqrtf(ss * (1.f / 64.f) + NORM_EPS);
    const float* ng = p.in[13] + l * GW + h * HD + 4 * q4;
    const bf16* gp = proj + (row0 + pos) * DIN + 12 * GW + h * HD + 4 * q4;
    bf16* yp = Y + (row0 + pos) * DM + 3 * GW + h * HD + 4 * q4;
#pragma unroll
    for (int et = 0; et < 4; ++et) {
        const f32x4 g4 = *(const f32x4*)(ng + 16 * et); const v2u gg = *(const v2u*)(gp + 16 * et);
        const float o0 = accO[et][0] * rstd * g4.x * siluf_(bflo(gg.x)), o1 = accO[et][1] * rstd * g4.y * siluf_(bfhi(gg.x));
        const float o2 = accO[et][2] * rstd * g4.z * siluf_(bflo(gg.y)), o3 = accO[et][3] * rstd * g4.w * siluf_(bfhi(gg.y));
        v2u o; o.x = pk2(o0, o1); o.y = pk2(o2, o3); *(v2u*)(yp + 16 * et) = o;
    }
}

template <int PASS>
__device__ __forceinline__ void mixer_a(unsigned char* lds, const Params& p, const bf16* proj, bf16* Y, int l, int item, int tid_in) {
    int tid = tid_in; asm volatile("" : "+v"(tid));
    const int lane = tid & 63, w = __builtin_amdgcn_readfirstlane(tid >> 6), c16 = lane & 15, q4 = lane >> 4;
    const int c = item & 31, bh = item >> 5, b = bh >> 2, h = bh & 3;
    const size_t row0 = (size_t)b * SEQ;
    bf16* Xs = (bf16*)(lds + L_KS); bf16* Wat = (bf16*)(lds + L_WAT); bf16* Wxt = (bf16*)(lds + L_WXT);
    float* aS = (float*)(lds + L_AS); float* uS = (float*)(lds + L_US); float* segA = (float*)(lds + L_SEGA); float* segH = (float*)(lds + L_SEGH);
    const int ch = tid & 63, blk = tid >> 6, col = h * HD + ch;
    __syncthreads();
    {
        const float* cwp = p.in[4] + (size_t)l * 4 * GW + col;
        const float cw0 = cwp[0], cw1 = cwp[GW], cw2 = cwp[2 * GW], cw3 = cwp[3 * GW], cb = p.in[5][l * GW + col];
        const int t0 = c * 128 + 16 * blk;
        const bf16* xp = proj + (row0 + t0) * DIN + col;
        float xm3 = (t0 >= 3) ? bf1(*(xp - 3 * (ptrdiff_t)DIN)) : 0.f, xm2 = (t0 >= 2) ? bf1(*(xp - 2 * (ptrdiff_t)DIN)) : 0.f, xm1 = (t0 >= 1) ? bf1(*(xp - (ptrdiff_t)DIN)) : 0.f;
#pragma unroll
        for (int i = 0; i < 16; ++i) {
            const float x = bf1(xp[(size_t)i * DIN]);
            const float xc = cb + cw0 * xm3 + cw1 * xm2 + cw2 * xm1 + cw3 * x;
            Xs[(16 * blk + i) * 72 + ch] = f2bf(xc);
            xm3 = xm2; xm2 = xm1; xm1 = x;
        }
        const float* wa = p.in[6] + (size_t)(l * NH + h) * 4096; const float* wx = p.in[8] + (size_t)(l * NH + h) * 4096;
#pragma unroll
        for (int k = 0; k < 8; ++k) { const int idx = tid + 512 * k, i = idx >> 6, j = idx & 63; Wat[j * 72 + i] = f2bf(wa[idx]); Wxt[j * 72 + i] = f2bf(wx[idx]); }
    }
    __syncthreads();
    {
        const bf16x8 x0 = *(const bf16x8*)(Xs + (16 * w + c16) * 72 + 8 * q4), x1 = *(const bf16x8*)(Xs + (16 * w + c16) * 72 + 32 + 8 * q4);
#pragma unroll
        for (int jt = 0; jt < 4; ++jt) {
            f32x4 ga = {0.f, 0.f, 0.f, 0.f}, gx = {0.f, 0.f, 0.f, 0.f};
            ga = MFMA16(x0, *(const bf16x8*)(Wat + (16 * jt + c16) * 72 + 8 * q4), ga); ga = MFMA16(x1, *(const bf16x8*)(Wat + (16 * jt + c16) * 72 + 32 + 8 * q4), ga);
            gx = MFMA16(x0, *(const bf16x8*)(Wxt + (16 * jt + c16) * 72 + 8 * q4), gx); gx = MFMA16(x1, *(const bf16x8*)(Wxt + (16 * jt + c16) * 72 + 32 + 8 * q4), gx);
            const int j = 16 * jt + c16, cj = l * GW + h * HD + j;
            const float ba = p.in[7][cj], bx = p.in[9][cj];
            const float lam = p.in[10][cj];
            const float lsl = -(fmaxf(-lam, 0.f) + log1pf(__expf(-fabsf(lam))));
#pragma unroll
            for (int r = 0; r < 4; ++r) {
                const int t = 16 * w + 4 * q4 + r;
                const float rr = sigmoidf_(ga[r] + ba), ii = sigmoidf_(gx[r] + bx);
                const float la = 8.f * rr * lsl;
                const float a = __expf(la), mult = sqrtf(fmaxf(-expm1f(2.f * la), 0.f));
                aS[t * 68 + j] = a; uS[t * 68 + j] = mult * ii * bf1(Xs[t * 72 + j]);
            }
        }
    }
    __syncthreads();
    {
        float As = 1.f, Hs = 0.f;
#pragma unroll
        for (int i = 0; i < 16; ++i) { const float a = aS[(16 * blk + i) * 68 + ch], u = uS[(16 * blk + i) * 68 + ch]; Hs = a * Hs + u; As *= a; }
        segA[blk * 64 + ch] = As; segH[blk * 64 + ch] = Hs;
    }
    __syncthreads();
    float* asum = (float*)(p.ws + WS_ASUM);
    if (PASS == 1) {
        if (blk == 7) {
            float A = 1.f, H = 0.f;
#pragma unroll
            for (int s = 0; s < 8; ++s) { const float sa = segA[s * 64 + ch]; H = sa * H + segH[s * 64 + ch]; A *= sa; }
            asum[((size_t)item * 64 + ch) * 2] = A; asum[((size_t)item * 64 + ch) * 2 + 1] = H;
        }
    } else {
        float hc = 0.f;
        for (int j = 0; j < c; ++j) { const float2 al = *(const float2*)(asum + ((size_t)(bh * 32 + j) * 64 + ch) * 2); hc = al.x * hc + al.y; }
        for (int s = 0; s < blk; ++s) hc = segA[s * 64 + ch] * hc + segH[s * 64 + ch];
        const int t0 = c * 128 + 16 * blk;
        const bf16* gp = proj + (row0 + t0) * DIN + GW + col;
        bf16* yp = Y + (row0 + t0) * DM + col;
#pragma unroll
        for (int i = 0; i < 16; ++i) {
            hc = aS[(16 * blk + i) * 68 + ch] * hc + uS[(16 * blk + i) * 68 + ch];
            yp[(size_t)i * DM] = f2bf(gelu_tanh_(bf1(gp[(size_t)i * DIN])) * hc);
        }
    }
}

__global__ void __launch_bounds__(512, 2) fwd_megakernel(Params p) {
    extern __shared__ __attribute__((aligned(16))) unsigned char lds[];
    cg::grid_group grid = cg::this_grid();
    const int G = gridDim.x;
#define GRID_SYNC() do { __builtin_amdgcn_fence(__ATOMIC_RELEASE, "agent"); asm volatile("s_waitcnt vmcnt(0) lgkmcnt(0)" ::: "memory"); grid.sync(); __builtin_amdgcn_fence(__ATOMIC_ACQUIRE, "agent"); asm volatile("s_waitcnt vmcnt(0)" ::: "memory"); } while (0)
#define FRESH_TID() int tid = threadIdx.x; asm volatile("" : "+v"(tid)); const int lane = tid & 63, wave = tid >> 6, gw = blockIdx.x * 8 + wave, ngw = G * 8; (void)lane; (void)gw; (void)ngw;
    bf16* XN = (bf16*)(p.ws + WS_XN); bf16* PROJ = (bf16*)(p.ws + WS_PROJ); bf16* Y = (bf16*)(p.ws + WS_Y); bf16* U = (bf16*)(p.ws + WS_U);
    PG8_LAS unsigned char* glds = (PG8_LAS unsigned char*)lds;

    { FRESH_TID(); prologue(p, lds, tid); }
    GRID_SYNC();

    for (int l = 0; l < DEPTH; ++l) {
        const bf16* Wl = (const bf16*)(p.ws + WS_W + (size_t)l * W_LAYER_B);
        const bf16* Win_t = Wl; const bf16* Wout_t = Wl + (size_t)DIN * DM; const bf16* Wup_t = Wout_t + (size_t)DM * DM; const bf16* Wdn_t = Wup_t + (size_t)DFF * DM;
        {
            pg8::Gemm g{XN, Win_t, M, DIN, DM}; pg8::StaticOrder S; S.init(M, DIN, G, (int)blockIdx.x);
            pg8::EpiBf16<0> E{PROJ, DIN, nullptr, 0, 0, 1.f};
            pg8::gemm_phase<pg8::EpiBf16<0>, pg8::StaticOrder, true, true>(glds, g, S, E);
        }
        GRID_SYNC();
#if !defined(MK_SKELETON)
        { FRESH_TID();
        for (int it = blockIdx.x; it < 3 * NITEM; it += G) {
            const int kind = it / NITEM, item = it % NITEM;
#ifndef MK_SKIP_D
            if (kind == 0) mixer_d_pass1(lds, p, PROJ, l, item, tid);
#endif
#ifndef MK_SKIP_B
            if (kind == 1) mixer_b_pass1(lds, p, PROJ, item, tid);
#endif
#ifndef MK_SKIP_A
            if (kind == 2) mixer_a<1>(lds, p, PROJ, Y, l, item, tid);
#endif
        } }
        GRID_SYNC();
        { FRESH_TID();
        for (int it = blockIdx.x; it < 4 * NITEM; it += G) {
            const int kind = it / NITEM, item = it % NITEM;
#ifndef MK_SKIP_C
            if (kind == 0) mixer_c_item(lds, PROJ, Y, item, tid);
#endif
#ifndef MK_SKIP_D
            if (kind == 1) mixer_d_pass2(lds, p, PROJ, Y, l, item, tid);
#endif
#ifndef MK_SKIP_B
            if (kind == 2) mixer_b_pass2(lds, p, PROJ, Y, l, item, tid);
#endif
#ifndef MK_SKIP_A
            if (kind == 3) mixer_a<2>(lds, p, PROJ, Y, l, item, tid);
#endif
        } }
        __syncthreads();
#else
        { FRESH_TID(); for (int m = gw; m < M; m += ngw) { const v4u* s = (const v4u*)(PROJ + (size_t)m * DIN); v4u* d = (v4u*)(Y + (size_t)m * DM); d[lane] = s[lane]; d[lane + 64] = s[lane + 64]; } }
#endif
        GRID_SYNC();
        {
            pg8::Gemm g{Y, Wout_t, M, DM, DM}; pg8::StaticOrder S; S.init(M, DM, G, (int)blockIdx.x);
            pg8::EpiRes E{p.out, DM, ALPHA};
            pg8::gemm_phase<pg8::EpiRes, pg8::StaticOrder, true, true>(glds, g, S, E);
        }
        GRID_SYNC();
        { FRESH_TID(); ln_phase(p.in[15] + l * DM, p.in[16] + l * DM, p.out, XN, gw, ngw, lane); }
        GRID_SYNC();
        {
            pg8::Gemm g{XN, Wup_t, M, DFF, DM}; pg8::StaticOrder S; S.init(M, DFF, G, (int)blockIdx.x);
            pg8::EpiBf16<2> E{U, DFF, nullptr, 0, 0, 1.f};
            pg8::gemm_phase<pg8::EpiBf16<2>, pg8::StaticOrder, true, true>(glds, g, S, E);
        }
        GRID_SYNC();
        {
            pg8::Gemm g{U, Wdn_t, M, DM, DFF}; pg8::StaticOrder S; S.init(M, DM, G, (int)blockIdx.x);
            pg8::EpiRes E{p.out, DM, ALPHA};
            pg8::gemm_phase<pg8::EpiRes, pg8::StaticOrder, true, true>(glds, g, S, E);
        }
        GRID_SYNC();
        { FRESH_TID(); ln_phase(p.in[19] + l * DM, p.in[20] + l * DM, p.out, XN, gw, ngw, lane); }
        if (l + 1 < DEPTH) GRID_SYNC();
    }
}

extern "C" void kernel_launch(void* const* d_in, const int* in_sizes, int n_in, void* d_out, int out_size, void* d_ws, size_t ws_size, hipStream_t stream) {
    static int grid_blocks = 0;
    if (grid_blocks == 0) {
        if (n_in != 21 || out_size != M * DM || ws_size < WS_END) { fprintf(stderr, "kernel_launch: unexpected shapes (n_in %d out %d ws %zu)\n", n_in, out_size, ws_size); grid_blocks = -1; return; }
        int dev = 0, cus = 0, per_cu = 0;
        hipGetDevice(&dev);
        hipDeviceGetAttribute(&cus, hipDeviceAttributeMultiprocessorCount, dev);
        if (hipFuncSetAttribute((const void*)fwd_megakernel, hipFuncAttributeMaxDynamicSharedMemorySize, LDS_BYTES) != hipSuccess) { fprintf(stderr, "kernel_launch: hipFuncSetAttribute failed\n"); grid_blocks = -1; return; }
        if (hipOccupancyMaxActiveBlocksPerMultiprocessor(&per_cu, (const void*)fwd_megakernel, 512, LDS_BYTES) != hipSuccess || per_cu < 1) { fprintf(stderr, "kernel_launch: occupancy query gave %d\n", per_cu); per_cu = 1; }
        (void)hipGetLastError();
        grid_blocks = cus * 1;
        if (per_cu < 1) grid_blocks = cus;
    }
    if (grid_blocks < 0) return;
    Params p{};
    for (int i = 0; i < 21; ++i) p.in[i] = (const float*)d_in[i];
    p.out = (float*)d_out; p.ws = (unsigned char*)d_ws;
    void* args[] = {&p};
    hipError_t e = hipLaunchCooperativeKernel((const void*)fwd_megakernel, dim3(grid_blocks), dim3(512), args, LDS_BYTES, stream);
    if (e != hipSuccess) fprintf(stderr, "cooperative launch failed: %s (grid %d)\n", hipGetErrorString(e), grid_blocks);
}
```

```cpp
#include <hip/hip_runtime.h>
#include <hip/hip_cooperative_groups.h>
#include <cstdio>
#include <cstdint>
namespace cg = cooperative_groups;
namespace pg8 {
#define PG8_LAS __attribute__((address_space(3)))
typedef unsigned short bf16_t;
typedef short bf16x8 __attribute__((ext_vector_type(8)));
typedef float f32x4 __attribute__((ext_vector_type(4)));
typedef unsigned u32x4 __attribute__((ext_vector_type(4)));
constexpr int BM = 256, BK = 64, HALF = 128, HTB = HALF * BK * 2  , STAGE_BYTES = 8 * HTB, NXCD = 8, WGM = 8;

__host__ __device__ __forceinline__ int lds_byte(int r, int c) { const int st = (r >> 4) * 2 + (c >> 5), rr = r & 15, cc = c & 31, ob = rr * 64 + cc * 2; return st * 1024 + (ob ^ (((ob >> 9) & 1) << 5)); }
__host__ __device__ __forceinline__ void stage_rc(int b, int& R, int& C) { const int st = b / 1024, sb = b % 1024, swz = sb ^ (((sb >> 9) & 1) << 5); R = (st >> 1) * 16 + swz / 64; C = (st & 1) * 32 + (swz % 64) / 2; }
__host__ __device__ __forceinline__ int perm32(int rho) { const int n = rho >> 4, i = rho & 15; return 8 * (i >> 2) + 4 * n + (i & 3); }

struct Unit { int pm, pn; };
struct Gemm { const bf16_t* A; const bf16_t* Bt; int M, N, K; };

struct StaticOrder {
    int nM, nN, nwg, G, c;
    __host__ __device__ void init(int M, int N, int G_, int c_) { nM = M / BM; nN = N / BM; nwg = nM * nN; G = G_; c = c_; }
    __host__ __device__ bool next(int i, Unit& u) const {
        const long L = (long)i * G + c; if (L >= nwg) return false;
        int wgid = (int)L; { const int q = nwg / NXCD, r = nwg % NXCD, xcd = wgid % NXCD, off = wgid / NXCD; wgid = (xcd < r ? xcd * (q + 1) : r * (q + 1) + (xcd - r) * q) + off; }
        const int nig = WGM * nN, gid = wgid / nig, fm = gid * WGM, gsz = (nM - fm) < WGM ? (nM - fm) : WGM;
        u.pm = fm + ((wgid % nig) % gsz); u.pn = (wgid % nig) / gsz; return true;
    }
    __device__ __forceinline__ void a_ready(const Unit&) const {}
    __device__ __forceinline__ void done(const Unit&) const {}
};

__device__ __forceinline__ unsigned cvt_pk_bf16(float lo, float hi) { unsigned r; asm volatile("v_cvt_pk_bf16_f32 %0, %1, %2" : "=v"(r) : "v"(lo), "v"(hi)); return r; }
typedef float f32x2 __attribute__((ext_vector_type(2)));
__device__ __forceinline__ f32x2 gelu_pk(f32x2 v) {
    const f32x2 av = __builtin_elementwise_abs(v), d = av * 0.2316418882f + 1.0f;
    f32x2 t; t.x = __builtin_amdgcn_rcpf(d.x); t.y = __builtin_amdgcn_rcpf(d.y);
    f32x2 q = t * 0.5307027145f + (-0.7265760135f); q = q * t + 0.7107068705f; q = q * t + (-0.142248368f); q = q * t + 0.127414796f; q = q * t;
    const f32x2 s = (v * v) * (-0.72134752044f);
    f32x2 e; e.x = __builtin_amdgcn_exp2f(s.x); e.y = __builtin_amdgcn_exp2f(s.y);
    const f32x2 m = v * (q * e), r = v - m;
    f32x2 o; o.x = v.x < 0.f ? m.x : r.x; o.y = v.y < 0.f ? m.y : r.y; return o;
}

template <int ACT  > struct EpiBf16 {
    static constexpr bool PERM = true, AFTER_DRAIN = false; static_assert(ACT >= 0 && ACT <= 2, "EpiBf16: ACT is 0 (none), 1 (gelu_pk) or 2 (squared relu)");
    bf16_t* O; int ldc; const float* bias; int split_cols; size_t split_stride; float scale0;
    __device__ __forceinline__ void operator()(const f32x4 (&acc)[2][2][4][2], const Unit& u, int wr, int wc, int fr, int fq) const {
        const int row0 = u.pm * BM + wr * 64 + fr; int colt = u.pn * BM; bf16_t* base = O;
        float sc = 1.f; if (split_cols) { const int t = colt / split_cols; base += (size_t)t * split_stride; colt -= t * split_cols; if (t == 0) sc = scale0; }
        const int col0 = colt + wc * 32 + 8 * fq, bcol0 = u.pn * BM + wc * 32 + 8 * fq;
        f32x4 bv[2][2];
#pragma unroll
        for (int bj = 0; bj < 2; ++bj)
#pragma unroll
            for (int n = 0; n < 2; ++n) bv[bj][n] = bias ? *(const f32x4*)(bias + bcol0 + bj * HALF + 4 * n) : (f32x4){0.f, 0.f, 0.f, 0.f};
#pragma unroll
        for (int ai = 0; ai < 2; ++ai)
#pragma unroll
            for (int m = 0; m < 4; ++m) { bf16_t* rowp = base + (size_t)(row0 + ai * HALF + m * 16) * ldc + col0;
#pragma unroll
                for (int bj = 0; bj < 2; ++bj) { f32x4 v0 = acc[ai][bj][m][0] + bv[bj][0], v1 = acc[ai][bj][m][1] + bv[bj][1];
                    if (ACT == 1) { f32x2 a = gelu_pk((f32x2){v0[0], v0[1]}), b = gelu_pk((f32x2){v0[2], v0[3]}), c = gelu_pk((f32x2){v1[0], v1[1]}), d = gelu_pk((f32x2){v1[2], v1[3]});
                        v0 = (f32x4){a.x, a.y, b.x, b.y}; v1 = (f32x4){c.x, c.y, d.x, d.y}; }
                    if (ACT == 2) { v0 = __builtin_elementwise_max(v0, (f32x4){0.f, 0.f, 0.f, 0.f}); v1 = __builtin_elementwise_max(v1, (f32x4){0.f, 0.f, 0.f, 0.f}); v0 = v0 * v0; v1 = v1 * v1; }
                    v0 = v0 * sc; v1 = v1 * sc; u32x4 w; w.x = cvt_pk_bf16(v0[0], v0[1]); w.y = cvt_pk_bf16(v0[2], v0[3]); w.z = cvt_pk_bf16(v1[0], v1[1]); w.w = cvt_pk_bf16(v1[2], v1[3]);
                    *(u32x4*)(rowp + bj * HALF) = w; } }
    }
};

struct PanelStats {
    unsigned* xbuf;
    unsigned* cnt;
    unsigned* tmo;
    int ntn; float eps;
    unsigned code;
    __device__ __forceinline__ bool run(const f32x4 (&v)[2][2][4][2], const Unit& u, int wr, int wc, int fr, int fq, PG8_LAS unsigned char* lds, int wid, int lane) const {
        typedef float f32x2v __attribute__((ext_vector_type(2)));
        PG8_LAS f32x2v* P = (PG8_LAS f32x2v*)lds;
        PG8_LAS f32x2v* S = (PG8_LAS f32x2v*)(lds + 8192);
        PG8_LAS unsigned* flag = (PG8_LAS unsigned*)(lds + 8192 + 2048);
#pragma unroll
        for (int ai = 0; ai < 2; ++ai)
#pragma unroll
            for (int m = 0; m < 4; ++m) {
                float s = 0.f;
#pragma unroll
                for (int bj = 0; bj < 2; ++bj)
#pragma unroll
                    for (int n = 0; n < 2; ++n) { const f32x4 x = v[ai][bj][m][n]; s += (x[0] + x[1]) + (x[2] + x[3]); }
                s += __shfl_xor(s, 16); s += __shfl_xor(s, 32);
                const float mw = s * (1.0f / 64.0f); float q = 0.f;
#pragma unroll
                for (int bj = 0; bj < 2; ++bj)
#pragma unroll
                    for (int n = 0; n < 2; ++n) { const f32x4 d = v[ai][bj][m][n] - mw; q += (d[0] * d[0] + d[1] * d[1]) + (d[2] * d[2] + d[3] * d[3]); }
                q += __shfl_xor(q, 16); q += __shfl_xor(q, 32);
                if (fq == 0) P[(ai * HALF + wr * 64 + m * 16 + fr) * 4 + wc] = (f32x2v){mw, q};
            }
        asm volatile("s_waitcnt lgkmcnt(0)" ::: "memory"); __builtin_amdgcn_s_barrier(); asm volatile("" ::: "memory");
#if defined(BROKEN_EXCHANGE_NO_WAIT)
#warning BROKEN CONTROL BUILD: the row-statistics exchange does not wait; results are wrong by design
        if (blockIdx.x >= 64) { const long long t0_ = clock64(); while (clock64() - t0_ < 60000) __builtin_amdgcn_s_sleep(8); }
#endif
        const int row = wid * 32 + (lane & 31);
        if (lane < 32) {
            const f32x2v a = P[row * 4 + 0], b = P[row * 4 + 1], c = P[row * 4 + 2], d = P[row * 4 + 3];
            const float mt = (a.x + b.x + c.x + d.x) * 0.25f;
            const float da = a.x - mt, db = b.x - mt, dc = c.x - mt, dd = d.x - mt;
            const float m2 = (a.y + b.y) + (c.y + d.y) + 64.0f * ((da * da + db * db) + (dc * dc + dd * dd));
            unsigned long long* slot = (unsigned long long*)xbuf + ((size_t)(u.pm * BM + row) * 4 + u.pn);
            __hip_atomic_store(slot, ((unsigned long long)__float_as_uint(m2) << 32) | __float_as_uint(mt), __ATOMIC_RELAXED, __HIP_MEMORY_SCOPE_AGENT);
        }
        asm volatile("s_waitcnt vmcnt(0)" ::: "memory");
        if (lane == 0) __hip_atomic_fetch_add(cnt + 64 * u.pm, 1u, __ATOMIC_RELAXED, __HIP_MEMORY_SCOPE_AGENT);
        if (wid == 0) {
            bool dead = false; const unsigned long long t0 = __builtin_amdgcn_s_memrealtime(); const unsigned want = 8u * (unsigned)ntn;
            for (;;) {
#if defined(BROKEN_EXCHANGE_NO_WAIT)
                break;
#endif
                if ((unsigned)__builtin_amdgcn_readfirstlane(__hip_atomic_load(cnt + 64 * u.pm, __ATOMIC_RELAXED, __HIP_MEMORY_SCOPE_AGENT)) >= want) break;
                if (__builtin_amdgcn_s_memrealtime() - t0 > 2000000ull) {
                    if (lane == 0) { unsigned expect = 0u; __hip_atomic_compare_exchange_strong(tmo + 1, &expect, code | (unsigned)(u.pm & 0xff), __ATOMIC_RELAXED, __ATOMIC_RELAXED, __HIP_MEMORY_SCOPE_AGENT);
                                     __hip_atomic_store(tmo, 1u, __ATOMIC_RELAXED, __HIP_MEMORY_SCOPE_AGENT); }
                    dead = true; break; }
                __builtin_amdgcn_s_sleep(2);
            }
            __builtin_amdgcn_fence(__ATOMIC_ACQUIRE, "agent");
            if (lane == 0) flag[0] = dead ? 1u : 0u;
        }
        asm volatile("s_waitcnt vmcnt(0) lgkmcnt(0)" ::: "memory"); __builtin_amdgcn_s_barrier(); asm volatile("" ::: "memory");
        const bool bad = flag[0] != 0u;
        if (lane < 32) {
            const unsigned long long* slot = (const unsigned long long*)xbuf + (size_t)(u.pm * BM + row) * 4; float mt[4], m2[4]; float ms = 0.f;
#pragma unroll
            for (int t = 0; t < 4; ++t) { if (t < ntn) { const unsigned long long w = __hip_atomic_load(slot + t, __ATOMIC_RELAXED, __HIP_MEMORY_SCOPE_AGENT); mt[t] = __uint_as_float((unsigned)w); m2[t] = __uint_as_float((unsigned)(w >> 32)); } else { mt[t] = 0.f; m2[t] = 0.f; } ms += mt[t]; }
            const float mean = ms / (float)ntn; float q = 0.f;
#pragma unroll
            for (int t = 0; t < 4; ++t) if (t < ntn) { const float dm = mt[t] - mean; q += m2[t] + 256.0f * dm * dm; }
            S[row] = (f32x2v){mean, 1.0f / sqrtf(q / (256.0f * (float)ntn) + eps)};
        }
        asm volatile("s_waitcnt lgkmcnt(0)" ::: "memory"); __builtin_amdgcn_s_barrier(); asm volatile("" ::: "memory");
        return bad;
    }
};
struct EpiLnRes {
    static constexpr bool PERM = false, AFTER_DRAIN = true;
    const float* base; float* out; int ldc; const float* bias; PanelStats st; unsigned poison;
    __device__ __forceinline__ void fused(f32x4 (&acc)[2][2][4][2], const Unit& u, int wr, int wc, int fr, int fq, PG8_LAS unsigned char* lds, int wid, int lane) const {
        typedef float f32x2v __attribute__((ext_vector_type(2)));
        const PG8_LAS f32x2v* S = (const PG8_LAS f32x2v*)(lds + 8192);
        const int col0 = u.pn * BM + wc * 32 + 4 * fq;
#pragma unroll
        for (int bj = 0; bj < 2; ++bj)
#pragma unroll
            for (int n = 0; n < 2; ++n) { const f32x4 bv = bias ? *(const f32x4*)(bias + col0 + bj * HALF + n * 16) : (f32x4){0.f, 0.f, 0.f, 0.f};
#pragma unroll
                for (int ai = 0; ai < 2; ++ai)
#pragma unroll
                    for (int m = 0; m < 4; ++m) acc[ai][bj][m][n] += bv; }
        f32x4 pre[4][2][2];
#pragma unroll
        for (int m = 0; m < 4; ++m) { const size_t off = (size_t)(u.pm * BM + wr * 64 + m * 16 + fr) * ldc + col0;
#pragma unroll
            for (int bj = 0; bj < 2; ++bj)
#pragma unroll
                for (int n = 0; n < 2; ++n) pre[m][bj][n] = *(const f32x4*)(base + off + bj * HALF + n * 16); }
        const bool bad = st.run(acc, u, wr, wc, fr, fq, lds, wid, lane) || poison != 0u;
        const float qnan = __builtin_nanf("");
#pragma unroll
        for (int ai = 0; ai < 2; ++ai)
#pragma unroll
            for (int m = 0; m < 4; ++m) { const int r = ai * HALF + wr * 64 + m * 16 + fr; const f32x2v sr = S[r]; const size_t off = (size_t)(u.pm * BM + r) * ldc + col0;
#pragma unroll
                for (int bj = 0; bj < 2; ++bj)
#pragma unroll
                    for (int n = 0; n < 2; ++n) { const f32x4 bs = ai == 0 ? pre[m][bj][n] : *(const f32x4*)(base + off + bj * HALF + n * 16); f32x4 o = bs + (acc[ai][bj][m][n] - sr.x) * sr.y;
                        if (bad) o = (f32x4){qnan, qnan, qnan, qnan}; *(f32x4*)(out + off + bj * HALF + n * 16) = o; }
                if (m & 1) asm volatile("" ::: "memory"); }
    }
};
struct EpiLnResLn {
    static constexpr bool PERM = false, AFTER_DRAIN = true;
    const float* base; float* out; bf16_t* xn; int ldc; const float* bias; PanelStats st1, st2; unsigned poison;
    __device__ __forceinline__ void fused(f32x4 (&acc)[2][2][4][2], const Unit& u, int wr, int wc, int fr, int fq, PG8_LAS unsigned char* lds, int wid, int lane) const {
        typedef float f32x2v __attribute__((ext_vector_type(2))); typedef unsigned u32x2v __attribute__((ext_vector_type(2)));
        const PG8_LAS f32x2v* S = (const PG8_LAS f32x2v*)(lds + 8192);
        const int col0 = u.pn * BM + wc * 32 + 4 * fq;
#pragma unroll
        for (int bj = 0; bj < 2; ++bj)
#pragma unroll
            for (int n = 0; n < 2; ++n) { const f32x4 bv = bias ? *(const f32x4*)(bias + col0 + bj * HALF + n * 16) : (f32x4){0.f, 0.f, 0.f, 0.f};
#pragma unroll
                for (int ai = 0; ai < 2; ++ai)
#pragma unroll
                    for (int m = 0; m < 4; ++m) acc[ai][bj][m][n] += bv; }
        bool bad = st1.run(acc, u, wr, wc, fr, fq, lds, wid, lane) || poison != 0u;
        const float qnan = __builtin_nanf("");
#pragma unroll
        for (int ai = 0; ai < 2; ++ai)
#pragma unroll
            for (int m = 0; m < 4; ++m) { const int r = ai * HALF + wr * 64 + m * 16 + fr; const f32x2v sr = S[r]; const size_t off = (size_t)(u.pm * BM + r) * ldc + col0;
#pragma unroll
                for (int bj = 0; bj < 2; ++bj)
#pragma unroll
                    for (int n = 0; n < 2; ++n) { const f32x4 bs = *(const f32x4*)(base + off + bj * HALF + n * 16); acc[ai][bj][m][n] = bs + (acc[ai][bj][m][n] - sr.x) * sr.y; }
                asm volatile("" : "+v"(acc[ai][0][m][0]), "+v"(acc[ai][0][m][1]), "+v"(acc[ai][1][m][0]), "+v"(acc[ai][1][m][1]));
                if (m & 1) asm volatile("" ::: "memory"); }
        const bool bad1 = bad;
        bad = st2.run(acc, u, wr, wc, fr, fq, lds, wid, lane) || bad;
#pragma unroll
        for (int ai = 0; ai < 2; ++ai)
#pragma unroll
            for (int m = 0; m < 4; ++m) { const int r = ai * HALF + wr * 64 + m * 16 + fr; const f32x2v sr = S[r]; const size_t off = (size_t)(u.pm * BM + r) * ldc + col0;
#pragma unroll
                for (int bj = 0; bj < 2; ++bj)
#pragma unroll
                    for (int n = 0; n < 2; ++n) { const f32x4 x1 = acc[ai][bj][m][n]; *(f32x4*)(out + off + bj * HALF + n * 16) = bad1 ? (f32x4){qnan, qnan, qnan, qnan} : x1;
                        const f32x4 o = (x1 - sr.x) * sr.y; u32x2v w; w.x = cvt_pk_bf16(o[0], o[1]); w.y = cvt_pk_bf16(o[2], o[3]);
                        if (bad) { w.x = 0x7fc07fc0u; w.y = 0x7fc07fc0u; } *(u32x2v*)(xn + off + bj * HALF + n * 16) = w; }
                asm volatile("" ::: "memory"); }
    }
};

template <class Epi, class Sched, bool ALIGN_EPI = false, bool SP2 = false>
__device__ __forceinline__ void gemm_phase(PG8_LAS unsigned char* lds, const Gemm g, const Sched& S, const Epi& E) {
    int tid_l = threadIdx.x; asm volatile("" : "+v"(tid_l)); const int tid = tid_l, wid = __builtin_amdgcn_readfirstlane(tid >> 6), lane = tid & 63, wr = wid >> 2, wc = wid & 3, fr = lane & 15, fq = lane >> 4;
    const int K = g.K, nt = K / BK;
    unsigned voffA[2], voffB[2];
#pragma unroll
    for (int i = 0; i < 2; ++i) { int R, C; stage_rc(tid * 16 + i * 8192, R, C); const int Rb = Epi::PERM ? ((R & ~31) + perm32(R & 31)) : R;
        voffA[i] = (unsigned)(R * K + C) * 2u; voffB[i] = (unsigned)(Rb * K + C) * 2u; }
    const size_t kstep = (size_t)(BK * 2);
    const size_t hstep = (size_t)HALF * K * 2;
    const size_t tstep = 2 * hstep;
    const unsigned ldsw = (unsigned)wid * 1024u;
    const int aoff = lds_byte(wr * 64 + fr, fq * 8), boff = lds_byte(wc * 32 + fr, fq * 8);
#define PG8_SA(b, h) (((b) * 2 + (h)) * HTB)
#define PG8_SB(b, h) ((4 + (b) * 2 + (h)) * HTB)
#define PG8_STAGE(bufoff, gbase, voff) do { _Pragma("unroll") for (int _i = 0; _i < 2; ++_i) \
        __builtin_amdgcn_global_load_lds((const unsigned*)((const char*)(gbase) + (voff)[_i]), (PG8_LAS unsigned*)(lds + (bufoff) + ldsw + _i * 8192), 16, 0, 0); } while (0)
#define PG8_LDA(dst, b, h) do { _Pragma("unroll") for (int m = 0; m < 4; ++m) _Pragma("unroll") for (int k = 0; k < 2; ++k) dst[m][k] = *(const PG8_LAS bf16x8*)(lds + PG8_SA(b, h) + aoff + m * 2048 + k * 1024); } while (0)
#define PG8_LDB(dst, b, h) do { _Pragma("unroll") for (int n = 0; n < 2; ++n) _Pragma("unroll") for (int k = 0; k < 2; ++k) dst[n][k] = *(const PG8_LAS bf16x8*)(lds + PG8_SB(b, h) + boff + n * 2048 + k * 1024); } while (0)
#define PG8_MMA(ai, bj, At, Bt) do { __builtin_amdgcn_s_setprio(1); _Pragma("unroll") for (int m = 0; m < 4; ++m) _Pragma("unroll") for (int n = 0; n < 2; ++n) _Pragma("unroll") for (int k = 0; k < 2; ++k) \
        acc[ai][bj][m][n] = __builtin_amdgcn_mfma_f32_16x16x32_bf16(Bt[n][k], At[m][k], acc[ai][bj][m][n], 0, 0, 0); __builtin_amdgcn_s_setprio(0); } while (0)
#define PG8_WAIT_V(n) asm volatile("s_waitcnt vmcnt(" #n ")" ::: "memory")
#define PG8_WAIT_L(n) asm volatile("s_waitcnt lgkmcnt(" #n ")" ::: "memory")
#define PG8_BAR __builtin_amdgcn_s_barrier()
#define PG8_SCHED __builtin_amdgcn_sched_barrier(0)
    Unit cur, nxt; int ui = 0;
    if (!S.next(0, cur)) return;
    f32x4 acc[2][2][4][2];
#pragma unroll
    for (int a = 0; a < 2; ++a)
#pragma unroll
        for (int b = 0; b < 2; ++b)
#pragma unroll
            for (int m = 0; m < 4; ++m)
#pragma unroll
                for (int n = 0; n < 2; ++n) acc[a][b][m][n] = (f32x4){0.f, 0.f, 0.f, 0.f};
    bf16x8 At[4][2], B0[2][2], B1[2][2];
    const char* cA = (const char*)g.A + (size_t)cur.pm * tstep; const char* cB = (const char*)g.Bt + (size_t)cur.pn * tstep;
    S.a_ready(cur);
    if constexpr (SP2) {
        PG8_STAGE(PG8_SB(0, 0), cB, voffB); PG8_STAGE(PG8_SB(0, 1), cB + hstep, voffB); PG8_STAGE(PG8_SA(0, 0), cA, voffA); PG8_STAGE(PG8_SA(0, 1), cA + hstep, voffA);
        if (wr == 1) PG8_BAR;
        PG8_WAIT_V(2); PG8_BAR;
        PG8_STAGE(PG8_SB(1, 0), cB + kstep, voffB); PG8_STAGE(PG8_SA(1, 0), cA + kstep, voffA); PG8_STAGE(PG8_SB(1, 1), cB + hstep + kstep, voffB);
        PG8_WAIT_V(6); PG8_BAR;
    } else {
        PG8_STAGE(PG8_SB(0, 0), cB, voffB); PG8_STAGE(PG8_SA(0, 0), cA, voffA); PG8_STAGE(PG8_SB(0, 1), cB + hstep, voffB); PG8_STAGE(PG8_SA(0, 1), cA + hstep, voffA);
        if (wr == 1) PG8_BAR;
        PG8_WAIT_V(4); PG8_BAR;
        PG8_STAGE(PG8_SB(1, 0), cB + kstep, voffB); PG8_STAGE(PG8_SA(1, 0), cA + kstep, voffA); PG8_STAGE(PG8_SB(1, 1), cB + hstep + kstep, voffB);
        PG8_WAIT_V(6); PG8_BAR;
    }
    for (;;) {
        const bool has_next = S.next(ui + 1, nxt);
        const char* nA = has_next ? (const char*)g.A + (size_t)nxt.pm * tstep : cA; const char* nB = has_next ? (const char*)g.Bt + (size_t)nxt.pn * tstep : cB;
        for (int t = 0; t < nt; t += 2) {
            const bool last = (t == nt - 2);
            const char* a1 = cA + (size_t)(t + 1) * kstep;
            const char* a2 = last ? nA : cA + (size_t)(t + 2) * kstep; const char* b2 = last ? nB : cB + (size_t)(t + 2) * kstep;
            const char* a3 = a2 + kstep; const char* b3 = b2 + kstep;
            if (last && has_next) S.a_ready(nxt);
            if constexpr (SP2) {
            PG8_LDB(B0, 0, 0); PG8_LDB(B1, 0, 1); PG8_SCHED; PG8_LDA(At, 0, 0); PG8_STAGE(PG8_SA(1, 1), a1 + hstep, voffA);
            PG8_WAIT_V(8); PG8_WAIT_L(0); PG8_BAR; PG8_MMA(0, 0, At, B0); PG8_MMA(0, 1, At, B1); PG8_BAR; PG8_SCHED;
            PG8_LDA(At, 0, 1); PG8_STAGE(PG8_SB(0, 0), b2, voffB); PG8_STAGE(PG8_SB(0, 1), b2 + hstep, voffB); PG8_STAGE(PG8_SA(0, 0), a2, voffA);
            PG8_WAIT_V(8); PG8_WAIT_L(0); PG8_BAR; PG8_MMA(1, 0, At, B0); PG8_MMA(1, 1, At, B1); PG8_BAR; PG8_SCHED;
            PG8_LDB(B0, 1, 0); PG8_LDB(B1, 1, 1); PG8_SCHED; PG8_LDA(At, 1, 0); PG8_STAGE(PG8_SA(0, 1), a2 + hstep, voffA);
            PG8_WAIT_V(8); PG8_WAIT_L(0); PG8_BAR; PG8_MMA(0, 0, At, B0); PG8_MMA(0, 1, At, B1); PG8_BAR; PG8_SCHED;
            PG8_LDA(At, 1, 1); PG8_STAGE(PG8_SB(1, 0), b3, voffB); PG8_STAGE(PG8_SB(1, 1), b3 + hstep, voffB); PG8_STAGE(PG8_SA(1, 0), a3, voffA);
            PG8_WAIT_V(8); PG8_WAIT_L(0); PG8_BAR; PG8_MMA(1, 0, At, B0); PG8_MMA(1, 1, At, B1); PG8_BAR; PG8_SCHED;
            } else {
            PG8_LDB(B0, 0, 0); PG8_SCHED; PG8_LDA(At, 0, 0); PG8_STAGE(PG8_SA(1, 1), a1 + hstep, voffA);
            PG8_WAIT_L(8); PG8_BAR; PG8_WAIT_L(0); PG8_MMA(0, 0, At, B0); PG8_BAR; PG8_SCHED;
            PG8_LDB(B1, 0, 1); PG8_STAGE(PG8_SB(0, 0), b2, voffB);
            PG8_BAR; PG8_WAIT_L(0); PG8_MMA(0, 1, At, B1); PG8_BAR;
            PG8_LDA(At, 0, 1); PG8_STAGE(PG8_SA(0, 0), a2, voffA);
            PG8_BAR; PG8_WAIT_L(0); PG8_MMA(1, 0, At, B0); PG8_BAR; PG8_SCHED;
            PG8_STAGE(PG8_SB(0, 1), b2 + hstep, voffB);
            PG8_WAIT_V(6); PG8_BAR; PG8_MMA(1, 1, At, B1); PG8_BAR;
            PG8_LDB(B0, 1, 0); PG8_SCHED; PG8_LDA(At, 1, 0); PG8_STAGE(PG8_SA(0, 1), a2 + hstep, voffA);
            PG8_WAIT_L(8); PG8_BAR; PG8_WAIT_L(0); PG8_MMA(0, 0, At, B0); PG8_BAR; PG8_SCHED;
            PG8_LDB(B1, 1, 1); PG8_STAGE(PG8_SB(1, 0), b3, voffB);
            PG8_BAR; PG8_WAIT_L(0); PG8_MMA(0, 1, At, B1); PG8_BAR;
            PG8_LDA(At, 1, 1); PG8_STAGE(PG8_SA(1, 0), a3, voffA);
            PG8_BAR; PG8_WAIT_L(0); PG8_MMA(1, 0, At, B0); PG8_BAR; PG8_SCHED;
            PG8_STAGE(PG8_SB(1, 1), b3 + hstep, voffB);
            PG8_WAIT_V(6); PG8_BAR; PG8_MMA(1, 1, At, B1); PG8_BAR;
            }
        }
        if constexpr (ALIGN_EPI) { if (wr == 0) PG8_BAR; }
        if constexpr (!Epi::AFTER_DRAIN) { E(acc, cur, wr, wc, fr, fq); S.done(cur); }
        if (!has_next) break;
#pragma unroll
        for (int a = 0; a < 2; ++a)
#pragma unroll
            for (int b = 0; b < 2; ++b)
#pragma unroll
                for (int m = 0; m < 4; ++m)
#pragma unroll
                    for (int n = 0; n < 2; ++n) acc[a][b][m][n] = (f32x4){0.f, 0.f, 0.f, 0.f};
        cur = nxt; cA = nA; cB = nB; ++ui;
        if constexpr (ALIGN_EPI) { if (wr == 1) PG8_BAR; }
    }
    PG8_WAIT_V(0);
    if constexpr (!ALIGN_EPI) { if (wr == 0) PG8_BAR; }
    PG8_BAR;
    if constexpr (Epi::AFTER_DRAIN) { E.fused(acc, cur, wr, wc, fr, fq, lds, wid, lane); S.done(cur); }
#undef PG8_SA
#undef PG8_SB
#undef PG8_STAGE
#undef PG8_LDA
#undef PG8_LDB
#undef PG8_MMA
#undef PG8_WAIT_V
#undef PG8_WAIT_L
#undef PG8_BAR
#undef PG8_SCHED
}
}

namespace pg8 {
struct EpiRes {
    static constexpr bool PERM = false, AFTER_DRAIN = false;
    float* io; int ldc; float alpha;
    __device__ __forceinline__ void operator()(const f32x4 (&acc)[2][2][4][2], const Unit& u, int wr, int wc, int fr, int fq) const {
        const int col0 = u.pn * BM + wc * 32 + 4 * fq;
#pragma unroll
        for (int ai = 0; ai < 2; ++ai)
#pragma unroll
            for (int m = 0; m < 4; ++m) { float* rp = io + (size_t)(u.pm * BM + ai * HALF + wr * 64 + m * 16 + fr) * ldc + col0;
#pragma unroll
                for (int bj = 0; bj < 2; ++bj)
#pragma unroll
                    for (int n = 0; n < 2; ++n) { f32x4* p = (f32x4*)(rp + bj * HALF + n * 16); const f32x4 o = *p; *p = o * alpha + acc[ai][bj][m][n]; } }
    }
};
}

constexpr int BATCH = 4, SEQ = 4096, DM = 1024, DEPTH = 2, HD = 64, GW = 256, NH = 4, DIN = 3328, DFF = 4096, M = BATCH * SEQ;
constexpr float LN_EPS = 1e-5f, NORM_EPS = 1e-6f;
constexpr float ALPHA = 1.41421356237309515f;
constexpr int NCH = SEQ / 128;
constexpr int NITEM = BATCH * NH * NCH;

constexpr size_t MiB = 1u << 20;
constexpr size_t W_IN_B = (size_t)DIN * DM * 2, W_OUT_B = (size_t)DM * DM * 2, W_UP_B = (size_t)DFF * DM * 2, W_DN_B = (size_t)DM * DFF * 2;
constexpr size_t W_LAYER_B = W_IN_B + W_OUT_B + W_UP_B + W_DN_B;
constexpr size_t WS_W = 0;
constexpr size_t WS_CTL = 50 * MiB, CTL_ZERO_BYTES = 1 * MiB;
constexpr int CW_BAR = 4096;
constexpr size_t WS_XN = 52 * MiB;
constexpr size_t WS_PROJ = 84 * MiB;
constexpr size_t WS_Y = 188 * MiB;
constexpr size_t WS_U = 84 * MiB;
constexpr size_t WS_KVB = 220 * MiB;
constexpr size_t WS_KVD = 228 * MiB;
constexpr size_t WS_DVEC = 236 * MiB;
constexpr size_t WS_ASUM = 236 * MiB + 256 * 1024;
constexpr size_t WS_LB = 236 * MiB + 768 * 1024;
constexpr size_t WS_ROPE = 237 * MiB;
constexpr size_t WS_END = 238 * MiB;
static_assert(2 * W_LAYER_B <= WS_XN, "weights fit");

constexpr int LDS_BYTES = 147456;

typedef unsigned short bf16;
typedef unsigned v4u __attribute__((ext_vector_type(4)));
typedef unsigned v2u __attribute__((ext_vector_type(2)));
typedef float f32x4 __attribute__((ext_vector_type(4)));
typedef short bf16x8 __attribute__((ext_vector_type(8)));
#define LAS __attribute__((address_space(3)))
#define MFMA16(a, b, c) __builtin_amdgcn_mfma_f32_16x16x32_bf16((a), (b), (c), 0, 0, 0)

typedef float f32x2_ __attribute__((ext_vector_type(2)));
typedef __bf16 bf16x2_ __attribute__((ext_vector_type(2)));
__device__ __forceinline__ unsigned pk2(float lo, float hi) { f32x2_ v = {lo, hi}; bf16x2_ b = __builtin_convertvector(v, bf16x2_); return __builtin_bit_cast(unsigned, b); }
__device__ __forceinline__ float bflo(unsigned u) { return __uint_as_float(u << 16); }
__device__ __forceinline__ float bfhi(unsigned u) { return __uint_as_float(u & 0xffff0000u); }
__device__ __forceinline__ float bf1(bf16 u) { return __uint_as_float(((unsigned)u) << 16); }
__device__ __forceinline__ bf16 f2bf(float f) { return (bf16)(pk2(f, 0.f) & 0xffffu); }
__device__ __forceinline__ bf16x8 pack8(const float (&v)[8]) {
    v4u w; w.x = pk2(v[0], v[1]); w.y = pk2(v[2], v[3]); w.z = pk2(v[4], v[5]); w.w = pk2(v[6], v[7]);
    return __builtin_bit_cast(bf16x8, w);
}
__device__ __forceinline__ void unpack8(v4u w, float (&v)[8]) {
    v[0] = bflo(w.x); v[1] = bfhi(w.x); v[2] = bflo(w.y); v[3] = bfhi(w.y); v[4] = bflo(w.z); v[5] = bfhi(w.z); v[6] = bflo(w.w); v[7] = bfhi(w.w);
}
__device__ __forceinline__ float wave_sum(float v) {
#pragma unroll
    for (int o = 1; o < 64; o <<= 1) v += __shfl_xor(v, o);
    return v;
}
__device__ __forceinline__ float sigmoidf_(float x) { return __builtin_amdgcn_rcpf(1.f + __expf(-x)); }
__device__ __forceinline__ float siluf_(float x) { return x * sigmoidf_(x); }
__device__ __forceinline__ float gelu_tanh_(float x) { const float u = 0.7978845608028654f * (x + 0.044715f * x * x * x); const float t = 1.f - 2.f * __builtin_amdgcn_rcpf(1.f + __expf(2.f * u)); return 0.5f * x * (1.f + t); }
__device__ __forceinline__ float softplusf_(float z) { return fmaxf(z, 0.f) + __logf(1.f + __expf(-fabsf(z))); }

struct Params {
    const float* in[21];
    float* out;
    unsigned char* ws;
};

__device__ __forceinline__ void p0_transpose_item(const float* W, int K, int N, bf16* WT, float* scr, int item, int lane) {
    const int nblk = N / 32, kb = item / nblk, nb = item % nblk, k0 = 64 * kb, n0 = 32 * nb;
#pragma unroll 8
    for (int i = 0; i < 32; ++i) { const int kk = 2 * i + (lane >> 5); scr[kk * 33 + (lane & 31)] = W[(size_t)(k0 + kk) * N + n0 + (lane & 31)]; }
    asm volatile("s_waitcnt lgkmcnt(0)" ::: "memory");
    const int c = lane & 7;
#pragma unroll
    for (int j = 0; j < 4; ++j) { const int n = (lane >> 3) + 8 * j; const float* s = scr + (8 * c) * 33 + n;
        v4u o; o.x = pk2(s[0 * 33], s[1 * 33]); o.y = pk2(s[2 * 33], s[3 * 33]); o.z = pk2(s[4 * 33], s[5 * 33]); o.w = pk2(s[6 * 33], s[7 * 33]);
        *(v4u*)(WT + (size_t)(n0 + n) * K + k0 + 8 * c) = o; }
    asm volatile("s_waitcnt lgkmcnt(0)" ::: "memory");
}
__device__ __forceinline__ void ln_row(const float* src, const float* g, const float* b, float* dstf, bf16* dstb, int lane) {
    const f32x4* xr = (const f32x4*)src + lane;
    f32x4 v[4]; float s = 0.f;
#pragma unroll
    for (int j = 0; j < 4; ++j) { v[j] = xr[64 * j]; s += (v[j].x + v[j].y) + (v[j].z + v[j].w); }
    const float mean = wave_sum(s) * (1.f / DM); float s2 = 0.f;
#pragma unroll
    for (int j = 0; j < 4; ++j) { v[j] = v[j] - mean; s2 += (v[j].x * v[j].x + v[j].y * v[j].y) + (v[j].z * v[j].z + v[j].w * v[j].w); }
    const float rstd = 1.f / sqrtf(wave_sum(s2) * (1.f / DM) + LN_EPS);
#pragma unroll
    for (int j = 0; j < 4; ++j) {
        const f32x4 gg = ((const f32x4*)g)[lane + 64 * j], bb = ((const f32x4*)b)[lane + 64 * j];
        const f32x4 o = v[j] * rstd * gg + bb;
        ((f32x4*)dstf)[lane + 64 * j] = o;
        v2u w; w.x = pk2(o.x, o.y); w.y = pk2(o.z, o.w);
        ((v2u*)dstb)[lane + 64 * j] = w;
    }
}
__device__ __forceinline__ void ln_phase(const float* g, const float* b, float* io, bf16* xn, int gw, int ngw, int lane) {
    for (int m = gw; m < M; m += ngw) ln_row(io + (size_t)m * DM, g, b, io + (size_t)m * DM, xn + (size_t)m * DM, lane);
}

__device__ __forceinline__ void prologue(const Params& p, unsigned char* lds, int tid) {
    const int lane = tid & 63, wave = tid >> 6;
    const int gw = blockIdx.x * 8 + wave, ngw = gridDim.x * 8;
    float* scr = (float*)(lds + wave * 16384);
    constexpr int I_IN = (DM / 64) * (DIN / 32), I_OUT = (DM / 64) * (DM / 32), I_UP = (DM / 64) * (DFF / 32), I_DN = (DFF / 64) * (DM / 32);
    constexpr int I_L = I_IN + I_OUT + I_UP + I_DN;
    for (int it = gw; it < DEPTH * I_L; it += ngw) {
        const int l = it / I_L; int r = it % I_L;
        bf16* wb = (bf16*)(p.ws + WS_W + (size_t)l * W_LAYER_B);
        if (r < I_IN) { p0_transpose_item(p.in[3] + (size_t)l * DM * DIN, DM, DIN, wb, scr, r, lane); continue; } r -= I_IN;
        if (r < I_OUT) { p0_transpose_item(p.in[14] + (size_t)l * DM * DM, DM, DM, wb + (size_t)DIN * DM, scr, r, lane); continue; } r -= I_OUT;
        if (r < I_UP) { p0_transpose_item(p.in[17] + (size_t)l * DM * DFF, DM, DFF, wb + (size_t)DIN * DM + (size_t)DM * DM, scr, r, lane); continue; } r -= I_UP;
        p0_transpose_item(p.in[18] + (size_t)l * DFF * DM, DFF, DM, wb + (size_t)DIN * DM + (size_t)DM * DM + (size_t)DFF * DM, scr, r, lane);
    }
    for (int m = gw; m < M; m += ngw) ln_row(p.in[0] + (size_t)m * DM, p.in[1], p.in[2], p.out + (size_t)m * DM, (bf16*)(p.ws + WS_XN) + (size_t)m * DM, lane);
#if defined(MK_ZERO_DIAG)
    { v4u* z = (v4u*)(p.ws + WS_Y); const size_t n = (WS_LB - WS_Y) / 16; for (size_t i = (size_t)blockIdx.x * 512 + tid; i < n; i += (size_t)gridDim.x * 512) z[i] = (v4u){0u, 0u, 0u, 0u}; }
#endif
    {
        float* rc = (float*)(p.ws + WS_ROPE); float* rs = rc + SEQ * 32;
        for (int i = blockIdx.x * 512 + tid; i < SEQ * 32; i += gridDim.x * 512) {
            const int pos = i >> 5, f = i & 31;
            const float inv = powf(10000.f, -(float)(2 * f) / 64.f);
            const float ang = (float)pos * inv;
            const float n = rintf(ang * 0.15915494309189535f);
            float r = fmaf(-n, 6.2831854820251465f, ang); r = fmaf(-n, -1.7484555e-7f, r);
            rc[i] = __cosf(r); rs[i] = __sinf(r);
        }
    }
    if (blockIdx.x == 0 && tid < GW) {
        const float* lg = p.in[12]; float* lb = (float*)(p.ws + WS_LB);
        float mx = lg[tid]; for (int l = 1; l < DEPTH; ++l) mx = fmaxf(mx, lg[l * GW + tid]);
        float den = 0.f; for (int l = 0; l < DEPTH; ++l) den += expf(lg[l * GW + tid] - mx);
        const float p0 = expf(lg[tid] - mx) / den; float cum = 0.f;
        for (int l = 0; l < DEPTH; ++l) { cum += expf(lg[l * GW + tid] - mx) / den; lb[l * GW + tid] = cum - p0; }
    }
}

constexpr int L_KS = 0;
constexpr int L_VT = 18432;
constexpr int L_ST = 35840;
constexpr int L_BS = 45056;
constexpr int L_KF = 79872;
constexpr int L_TOT = 114688;
constexpr int L_FLAG = 120000;
constexpr int L_WAT = 18432, L_WXT = 27648, L_AS = 36864, L_US = 71680, L_SEGA = 106496, L_SEGH = 108544;

__device__ __forceinline__ void stage_vt(bf16* Vt, const bf16* Vg, int tid) {
    const int s = tid & 127, eg = tid >> 7;
    const bf16* src = Vg + (size_t)s * DIN + 16 * eg;
    const v4u a = *(const v4u*)src, c = *(const v4u*)(src + 8);
    bf16* vt = Vt + (16 * eg) * 136 + s;
    vt[0 * 136] = (bf16)(a.x & 0xffffu); vt[1 * 136] = (bf16)(a.x >> 16); vt[2 * 136] = (bf16)(a.y & 0xffffu); vt[3 * 136] = (bf16)(a.y >> 16);
    vt[4 * 136] = (bf16)(a.z & 0xffffu); vt[5 * 136] = (bf16)(a.z >> 16); vt[6 * 136] = (bf16)(a.w & 0xffffu); vt[7 * 136] = (bf16)(a.w >> 16);
    vt[8 * 136] = (bf16)(c.x & 0xffffu); vt[9 * 136] = (bf16)(c.x >> 16); vt[10 * 136] = (bf16)(c.y & 0xffffu); vt[11 * 136] = (bf16)(c.y >> 16);
    vt[12 * 136] = (bf16)(c.z & 0xffffu); vt[13 * 136] = (bf16)(c.z >> 16); vt[14 * 136] = (bf16)(c.w & 0xffffu); vt[15 * 136] = (bf16)(c.w >> 16);
}
__device__ __forceinline__ bf16x8 vt_frag2(const bf16* Vt, int e, int lo, int hi, int q4) {
    const v2u a = *(const v2u*)(Vt + e * 136 + 16 * lo + 4 * q4), c = *(const v2u*)(Vt + e * 136 + 16 * hi + 4 * q4);
    v4u w; w.x = a.x; w.y = a.y; w.z = c.x; w.w = c.y; return __builtin_bit_cast(bf16x8, w);
}
__device__ __forceinline__ void kv_product(const bf16* Kt, const bf16* Vt, float* out, int w, int c16, int q4) {
    const int dt = w >> 1, et0 = 2 * (w & 1);
    f32x4 acc[2] = {{0.f, 0.f, 0.f, 0.f}, {0.f, 0.f, 0.f, 0.f}};
#pragma unroll
    for (int ks = 0; ks < 4; ++ks) {
        const bf16x8 a = *(const bf16x8*)(Kt + (16 * dt + c16) * 136 + 32 * ks + 8 * q4);
#pragma unroll
        for (int e2 = 0; e2 < 2; ++e2) { const bf16x8 b = *(const bf16x8*)(Vt + (16 * (et0 + e2) + c16) * 136 + 32 * ks + 8 * q4); acc[e2] = MFMA16(a, b, acc[e2]); }
    }
#pragma unroll
    for (int e2 = 0; e2 < 2; ++e2)
#pragma unroll
        for (int r = 0; r < 4; ++r) out[(16 * dt + 4 * q4 + r) * 64 + 16 * (et0 + e2) + c16] = acc[e2][r];
}

__device__ __forceinline__ void c_tile(const bf16* Ks, const bf16x8 (&Qf)[2], int j, int sbase, int tq, int lane, int c16, int q4, float& R, float (&wv)[4]) {
    const bf16x8 k0 = *(const bf16x8*)(Ks + (16 * j + c16) * 72 + 8 * q4), k1 = *(const bf16x8*)(Ks + (16 * j + c16) * 72 + 32 + 8 * q4);
    f32x4 z = {0.f, 0.f, 0.f, 0.f};
    z = MFMA16(k0, Qf[0], z); z = MFMA16(k1, Qf[1], z);
    float lk[4], ls[4]; bool valid[4];
#pragma unroll
    for (int r = 0; r < 4; ++r) { const float zz = z[r] * 0.125f; valid[r] = (sbase + 16 * j + 4 * q4 + r) < tq; const float sp = softplusf_(zz); lk[r] = valid[r] ? -sp : 0.f; ls[r] = zz - sp; }
    const float suf2 = lk[3], suf1 = suf2 + lk[2], suf0 = suf1 + lk[1], T = suf0 + lk[0];
    const float t1 = __shfl(T, (lane + 16) & 63), t2 = __shfl(T, (lane + 32) & 63), t3 = __shfl(T, (lane + 48) & 63);
    const float X = (q4 < 3 ? t1 : 0.f) + (q4 < 2 ? t2 : 0.f) + (q4 < 1 ? t3 : 0.f);
    float tot = T + __shfl_xor(T, 16); tot += __shfl_xor(tot, 32);
    const float base = R + X;
    wv[0] = valid[0] ? __expf(ls[0] + base + suf0) : 0.f;
    wv[1] = valid[1] ? __expf(ls[1] + base + suf1) : 0.f;
    wv[2] = valid[2] ? __expf(ls[2] + base + suf2) : 0.f;
    wv[3] = valid[3] ? __expf(ls[3] + base) : 0.f;
    R += tot;
}
__device__ __forceinline__ void mixer_c_item(unsigned char* lds, const bf16* proj, bf16* Y, int item, int tid_in) {
    int tid = tid_in; asm volatile("" : "+v"(tid));
    const int lane = tid & 63, w = __builtin_amdgcn_readfirstlane(tid >> 6), c16 = lane & 15, q4 = lane >> 4;
    const int qb = 31 - (item & 31), bh = item >> 5, b = bh >> 2, h = bh & 3;
    const size_t row0 = (size_t)b * SEQ;
    const bf16* Qg = proj + 6 * GW + h * HD; const bf16* Kg = proj + 7 * GW + h * HD; const bf16* Vg = proj + 8 * GW + h * HD;
    bf16* Ks = (bf16*)(lds + L_KS); bf16* Vt = (bf16*)(lds + L_VT); volatile unsigned* flags = (volatile unsigned*)(lds + L_FLAG);
    const int tq = qb * 128 + 16 * w + c16;
    bf16x8 Qf[2];
    Qf[0] = *(const bf16x8*)(Qg + (row0 + tq) * DIN + 8 * q4); Qf[1] = *(const bf16x8*)(Qg + (row0 + tq) * DIN + 32 + 8 * q4);
    f32x4 accO[4];
#pragma unroll
    for (int et = 0; et < 4; ++et) accO[et] = (f32x4){0.f, 0.f, 0.f, 0.f};
    float R = 0.f; bool done = false;
    __syncthreads();
    for (int kb = qb; kb >= 0; --kb) {
        { const int s = tid >> 2, part = tid & 3; const bf16* src = Kg + (row0 + kb * 128 + s) * DIN + 16 * part;
          const v4u a = *(const v4u*)src, c = *(const v4u*)(src + 8); *(v4u*)(Ks + s * 72 + 16 * part) = a; *(v4u*)(Ks + s * 72 + 16 * part + 8) = c; }
        stage_vt(Vt, Vg + (row0 + kb * 128) * DIN, tid);
        __syncthreads();
        if (!done) {
            const int ptop = (kb == qb) ? (w >> 1) : 3;
            for (int pp = ptop; pp >= 0; --pp) {
                float wh[4], wl[4];
                c_tile(Ks, Qf, 2 * pp + 1, kb * 128, tq, lane, c16, q4, R, wh);
                c_tile(Ks, Qf, 2 * pp, kb * 128, tq, lane, c16, q4, R, wl);
                const float pv[8] = {wl[0], wl[1], wl[2], wl[3], wh[0], wh[1], wh[2], wh[3]};
                const bf16x8 P = pack8(pv);
#pragma unroll
                for (int et = 0; et < 4; ++et) accO[et] = MFMA16(vt_frag2(Vt, 16 * et + c16, 2 * pp, 2 * pp + 1, q4), P, accO[et]);
                if (__all(R < -104.f)) { done = true; break; }
            }
        }
        if (lane == 0) flags[w] = done ? 1u : 0u;
        __syncthreads();
        unsigned alld = 1u;
#pragma unroll
        for (int i = 0; i < 8; ++i) alld &= flags[i];
        if (alld) break;
    }
    bf16* yp = Y + (row0 + tq) * DM + 2 * GW + h * HD + 4 * q4;
#pragma unroll
    for (int et = 0; et < 4; ++et) { v2u o; o.x = pk2(accO[et][0], accO[et][1]); o.y = pk2(accO[et][2], accO[et][3]); *(v2u*)(yp + 16 * et) = o; }
}

__device__ __forceinline__ void rope8(const bf16* src, const float* rc, const float* rs, int pos, int part, float (&r1)[8], float (&r2)[8]) {
    float x1[8], x2[8];
    unpack8(*(const v4u*)(src + 8 * part), x1); unpack8(*(const v4u*)(src + 32 + 8 * part), x2);
    const f32x4 c0 = *(const f32x4*)(rc + pos * 32 + 8 * part), c1 = *(const f32x4*)(rc + pos * 32 + 8 * part + 4);
    const f32x4 s0 = *(const f32x4*)(rs + pos * 32 + 8 * part), s1 = *(const f32x4*)(rs + pos * 32 + 8 * part + 4);
    const float cc[8] = {c0.x, c0.y, c0.z, c0.w, c1.x, c1.y, c1.z, c1.w}, ss[8] = {s0.x, s0.y, s0.z, s0.w, s1.x, s1.y, s1.z, s1.w};
#pragma unroll
    for (int i = 0; i < 8; ++i) { r1[i] = x1[i] * cc[i] - x2[i] * ss[i]; r2[i] = x1[i] * ss[i] + x2[i] * cc[i]; }
}
__device__ __forceinline__ void mixer_b_pass1(unsigned char* lds, const Params& p, const bf16* proj, int item, int tid_in) {
    int tid = tid_in; asm volatile("" : "+v"(tid));
    const int lane = tid & 63, w = __builtin_amdgcn_readfirstlane(tid >> 6), c16 = lane & 15, q4 = lane >> 4;
    const int c = item & 31, bh = item >> 5, b = bh >> 2, h = bh & 3;
    const size_t row0 = (size_t)b * SEQ;
    const float* rc = (const float*)(p.ws + WS_ROPE); const float* rs = rc + SEQ * 32;
    bf16* Kt = (bf16*)(lds + L_KS); bf16* Vt = (bf16*)(lds + L_VT);
    const float lg2 = log2f(1.f - exp2f(-5.f - (float)h));
    __syncthreads();
    {
        const int s = tid & 127, part = tid >> 7, pos = c * 128 + s;
        float r1[8], r2[8];
        rope8(proj + (row0 + pos) * DIN + 3 * GW + h * HD, rc, rs, pos, part, r1, r2);
        const float sc = 0.125f * exp2f(lg2 * (float)(127 - s));
#pragma unroll
        for (int i = 0; i < 8; ++i) { Kt[(8 * part + i) * 136 + s] = f2bf(r1[i] * sc); Kt[(32 + 8 * part + i) * 136 + s] = f2bf(r2[i] * sc); }
    }
    stage_vt(Vt, proj + (row0 + c * 128) * DIN + 4 * GW + h * HD, tid);
    __syncthreads();
    kv_product(Kt, Vt, (float*)(p.ws + WS_KVB) + (size_t)item * 4096, w, c16, q4);
}
__device__ __forceinline__ void mixer_b_pass2(unsigned char* lds, const Params& p, const bf16* proj, bf16* Y, int l, int item, int tid_in) {
    int tid = tid_in; asm volatile("" : "+v"(tid));
    const int lane = tid & 63, w = __builtin_amdgcn_readfirstlane(tid >> 6), c16 = lane & 15, q4 = lane >> 4;
    const int c = item & 31, bh = item >> 5, b = bh >> 2, h = bh & 3;
    const size_t row0 = (size_t)b * SEQ;
    const float* rc = (const float*)(p.ws + WS_ROPE); const float* rs = rc + SEQ * 32;
    bf16* Ks = (bf16*)(lds + L_KS); bf16* Vt = (bf16*)(lds + L_VT); bf16* St = (bf16*)(lds + L_ST);
    const float lg2 = log2f(1.f - exp2f(-5.f - (float)h));
    __syncthreads();
    {
        const int e = tid & 63, dg = tid >> 6; const float Gam = exp2f(lg2 * 128.f);
        float S[8];
#pragma unroll
        for (int i = 0; i < 8; ++i) S[i] = 0.f;
        const float* kv = (const float*)(p.ws + WS_KVB) + (size_t)(bh * 32) * 4096 + (8 * dg) * 64 + e;
        for (int j = 0; j < c; ++j) {
#pragma unroll
            for (int i = 0; i < 8; ++i) S[i] = Gam * S[i] + kv[(size_t)j * 4096 + i * 64];
        }
        *(bf16x8*)(St + e * 72 + 8 * dg) = pack8(S);
    }
    {
        const int s = tid >> 2, part = tid & 3, pos = c * 128 + s;
        float r1[8], r2[8];
        rope8(proj + (row0 + pos) * DIN + 3 * GW + h * HD, rc, rs, pos, part, r1, r2);
#pragma unroll
        for (int i = 0; i < 8; ++i) { r1[i] *= 0.125f; r2[i] *= 0.125f; }
        *(bf16x8*)(Ks + s * 72 + 8 * part) = pack8(r1); *(bf16x8*)(Ks + s * 72 + 32 + 8 * part) = pack8(r2);
    }
    stage_vt(Vt, proj + (row0 + c * 128) * DIN + 4 * GW + h * HD, tid);
    __syncthreads();
    const int tl = 16 * w + c16, pos = c * 128 + tl;
    bf16x8 Qf[2];
    { float r1[8], r2[8]; rope8(proj + (row0 + pos) * DIN + 2 * GW + h * HD, rc, rs, pos, q4, r1, r2); Qf[0] = pack8(r1); Qf[1] = pack8(r2); }
    f32x4 accO[4];
    const float qd = exp2f(lg2 * (float)(tl + 1));
#pragma unroll
    for (int et = 0; et < 4; ++et) {
        f32x4 a = {0.f, 0.f, 0.f, 0.f};
        a = MFMA16(*(const bf16x8*)(St + (16 * et + c16) * 72 + 8 * q4), Qf[0], a);
        a = MFMA16(*(const bf16x8*)(St + (16 * et + c16) * 72 + 32 + 8 * q4), Qf[1], a);
        accO[et] = a * qd;
    }
    for (int pp = (w >> 1); pp >= 0; --pp) {
        float pv[8];
#pragma unroll
        for (int hh = 0; hh < 2; ++hh) {
            const int j = 2 * pp + hh;
            f32x4 z = {0.f, 0.f, 0.f, 0.f};
            z = MFMA16(*(const bf16x8*)(Ks + (16 * j + c16) * 72 + 8 * q4), Qf[0], z);
            z = MFMA16(*(const bf16x8*)(Ks + (16 * j + c16) * 72 + 32 + 8 * q4), Qf[1], z);
#pragma unroll
            for (int r = 0; r < 4; ++r) { const int df = tl - (16 * j + 4 * q4 + r); pv[4 * hh + r] = (df >= 0) ? z[r] * exp2f(lg2 * (float)df) : 0.f; }
        }
        const bf16x8 P = pack8(pv);
#pragma unroll
        for (int et = 0; et < 4; ++et) accO[et] = MFMA16(vt_frag2(Vt, 16 * et + c16, 2 * pp, 2 * pp + 1, q4), P, accO[et]);
    }
    float s = 0.f;
#pragma unroll
    for (int et = 0; et < 4; ++et) s += (accO[et][0] + accO[et][1]) + (accO[et][2] + accO[et][3]);
    s += __shfl_xor(s, 16); s += __shfl_xor(s, 32);
    const float mu = s * (1.f / 64.f); float qv = 0.f;
#pragma unroll
    for (int et = 0; et < 4; ++et)
#pragma unroll
        for (int r = 0; r < 4; ++r) { const float d = accO[et][r] - mu; qv += d * d; }
    qv += __shfl_xor(qv, 16); qv += __shfl_xor(qv, 32);
    const float rstd = 1.f / sqrtf(qv * (1.f / 64.f) + NORM_EPS);
    const float* ng = p.in[11] + l * GW + h * HD + 4 * q4;
    const bf16* gp = proj + (row0 + pos) * DIN + 5 * GW + h * HD + 4 * q4;
    bf16* yp = Y + (row0 + pos) * DM + 1 * GW + h * HD + 4 * q4;
#pragma unroll
    for (int et = 0; et < 4; ++et) {
        const f32x4 g4 = *(const f32x4*)(ng + 16 * et); const v2u gg = *(const v2u*)(gp + 16 * et);
        const float o0 = (accO[et][0] - mu) * rstd * g4.x * siluf_(bflo(gg.x)), o1 = (accO[et][1] - mu) * rstd * g4.y * siluf_(bfhi(gg.x));
        const float o2 = (accO[et][2] - mu) * rstd * g4.z * siluf_(bflo(gg.y)), o3 = (accO[et][3] - mu) * rstd * g4.w * siluf_(bfhi(gg.y));
        v2u o; o.x = pk2(o0, o1); o.y = pk2(o2, o3); *(v2u*)(yp + 16 * et) = o;
    }
}

__device__ __forceinline__ void d_gates(unsigned char* lds, const Params& p, const bf16* proj, int l, int bh, int c, int tid, float (&bl)[16], float (&kk)[16], float& bend) {
    const int ch = tid & 63, blk = tid >> 6, b = bh >> 2, h = bh & 3;
    const size_t row0 = (size_t)b * SEQ;
    float* tot = (float*)(lds + L_TOT);
    const float lb = ((const float*)(p.ws + WS_LB))[l * GW + h * HD + ch];
    const bf16* fp = proj + (row0 + c * 128 + 16 * blk) * DIN + 10 * GW + h * HD + ch;
    float run = 0.f;
#pragma unroll
    for (int i = 0; i < 16; ++i) {
        float x = bf1(fp[(size_t)i * DIN]); x = fminf(fmaxf(x, -80.f), 80.f);
        const float ex = __expf(-x), sg = __builtin_amdgcn_rcpf(1.f + ex);
        const float f = lb + (1.f - lb) * sg;
        run += __logf(fmaxf(f, 1e-30f));
        bl[i] = run; kk[i] = (1.f - lb) * (ex * sg);
    }
    tot[blk * 64 + ch] = run;
    __syncthreads();
    float pre = 0.f, all = 0.f;
#pragma unroll
    for (int s = 0; s < 8; ++s) { const float t = tot[s * 64 + ch]; all += t; pre += (s < blk) ? t : 0.f; }
#pragma unroll
    for (int i = 0; i < 16; ++i) bl[i] += pre;
    bend = all;
}
__device__ __forceinline__ void mixer_d_pass1(unsigned char* lds, const Params& p, const bf16* proj, int l, int item, int tid_in) {
    int tid = tid_in; asm volatile("" : "+v"(tid));
    const int lane = tid & 63, w = __builtin_amdgcn_readfirstlane(tid >> 6), c16 = lane & 15, q4 = lane >> 4;
    const int c = item & 31, bh = item >> 5, b = bh >> 2, h = bh & 3;
    const size_t row0 = (size_t)b * SEQ;
    bf16* Kt = (bf16*)(lds + L_KS); bf16* Vt = (bf16*)(lds + L_VT);
    __syncthreads();
    float bl[16], kk[16], bend;
    d_gates(lds, p, proj, l, bh, c, tid, bl, kk, bend);
    {
        const int ch = tid & 63, blk = tid >> 6;
        float k0[8], k1[8];
#pragma unroll
        for (int i = 0; i < 8; ++i) { k0[i] = kk[i] * __expf(bend - bl[i]); k1[i] = kk[8 + i] * __expf(bend - bl[8 + i]); }
        *(bf16x8*)(Kt + ch * 136 + 16 * blk) = pack8(k0); *(bf16x8*)(Kt + ch * 136 + 16 * blk + 8) = pack8(k1);
        if (blk == 0) ((float*)(p.ws + WS_DVEC))[(size_t)item * 64 + ch] = __expf(bend);
    }
    stage_vt(Vt, proj + (row0 + c * 128) * DIN + 11 * GW + h * HD, tid);
    __syncthreads();
    kv_product(Kt, Vt, (float*)(p.ws + WS_KVD) + (size_t)item * 4096, w, c16, q4);
}
__device__ __forceinline__ void mixer_d_pass2(unsigned char* lds, const Params& p, const bf16* proj, bf16* Y, int l, int item, int tid_in) {
    int tid = tid_in; asm volatile("" : "+v"(tid));
    const int lane = tid & 63, w = __builtin_amdgcn_readfirstlane(tid >> 6), c16 = lane & 15, q4 = lane >> 4;
    const int c = item & 31, bh = item >> 5, b = bh >> 2, h = bh & 3;
    const size_t row0 = (size_t)b * SEQ;
    bf16* Vt = (bf16*)(lds + L_VT); bf16* St = (bf16*)(lds + L_ST); float* bS = (float*)(lds + L_BS); float* kS = (float*)(lds + L_KF);
    __syncthreads();
    {
        float bl[16], kk[16], bend;
        d_gates(lds, p, proj, l, bh, c, tid, bl, kk, bend);
        const int ch = tid & 63, blk = tid >> 6;
#pragma unroll
        for (int i = 0; i < 16; ++i) { bS[(16 * blk + i) * 68 + ch] = bl[i]; kS[(16 * blk + i) * 68 + ch] = kk[i]; }
    }
    {
        const int e = tid & 63, dg = tid >> 6;
        float S[8];
#pragma unroll
        for (int i = 0; i < 8; ++i) S[i] = 0.f;
        const float* kv = (const float*)(p.ws + WS_KVD) + (size_t)(bh * 32) * 4096 + (8 * dg) * 64 + e;
        const float* dv = (const float*)(p.ws + WS_DVEC) + (size_t)(bh * 32) * 64 + 8 * dg;
        for (int j = 0; j < c; ++j) {
#pragma unroll
            for (int i = 0; i < 8; ++i) S[i] = dv[j * 64 + i] * S[i] + kv[(size_t)j * 4096 + i * 64];
        }
        *(bf16x8*)(St + e * 72 + 8 * dg) = pack8(S);
    }
    stage_vt(Vt, proj + (row0 + c * 128) * DIN + 11 * GW + h * HD, tid);
    __syncthreads();
    const int tl = 16 * w + c16, pos = c * 128 + tl;
    float qv[16], bt[16], Bp[16];
    { const bf16* qp = proj + (row0 + pos) * DIN + 9 * GW + h * HD + 8 * q4; float a[8], bb[8]; unpack8(*(const v4u*)qp, a); unpack8(*(const v4u*)(qp + 32), bb);
#pragma unroll
      for (int i = 0; i < 8; ++i) { qv[i] = a[i]; qv[8 + i] = bb[i]; } }
#pragma unroll
    for (int ks = 0; ks < 2; ++ks) {
        const f32x4 b0 = *(const f32x4*)(bS + tl * 68 + 32 * ks + 8 * q4), b1 = *(const f32x4*)(bS + tl * 68 + 32 * ks + 8 * q4 + 4);
        bt[8 * ks + 0] = b0.x; bt[8 * ks + 1] = b0.y; bt[8 * ks + 2] = b0.z; bt[8 * ks + 3] = b0.w; bt[8 * ks + 4] = b1.x; bt[8 * ks + 5] = b1.y; bt[8 * ks + 6] = b1.z; bt[8 * ks + 7] = b1.w;
        if (w > 0) {
            const f32x4 p0 = *(const f32x4*)(bS + (16 * w - 1) * 68 + 32 * ks + 8 * q4), p1 = *(const f32x4*)(bS + (16 * w - 1) * 68 + 32 * ks + 8 * q4 + 4);
            Bp[8 * ks + 0] = p0.x; Bp[8 * ks + 1] = p0.y; Bp[8 * ks + 2] = p0.z; Bp[8 * ks + 3] = p0.w; Bp[8 * ks + 4] = p1.x; Bp[8 * ks + 5] = p1.y; Bp[8 * ks + 6] = p1.z; Bp[8 * ks + 7] = p1.w;
        } else {
#pragma unroll
            for (int i = 0; i < 8; ++i) Bp[8 * ks + i] = 0.f;
        }
    }
    bf16x8 Qh[2], Qt[2];
#pragma unroll
    for (int ks = 0; ks < 2; ++ks) {
        float a[8], t[8];
#pragma unroll
        for (int i = 0; i < 8; ++i) { a[i] = qv[8 * ks + i] * __expf(bt[8 * ks + i]); t[i] = qv[8 * ks + i] * __expf(bt[8 * ks + i] - Bp[8 * ks + i]); }
        Qh[ks] = pack8(a); Qt[ks] = pack8(t);
    }
    f32x4 accO[4];
#pragma unroll
    for (int et = 0; et < 4; ++et) {
        f32x4 a = {0.f, 0.f, 0.f, 0.f};
        a = MFMA16(*(const bf16x8*)(St + (16 * et + c16) * 72 + 8 * q4), Qh[0], a);
        a = MFMA16(*(const bf16x8*)(St + (16 * et + c16) * 72 + 32 + 8 * q4), Qh[1], a);
        accO[et] = a;
    }
    for (int pp = 0; 2 * pp < w; ++pp) {
        float pv[8];
#pragma unroll
        for (int hh = 0; hh < 2; ++hh) {
            const int j = 2 * pp + hh;
            if (j < w) {
                f32x4 z = {0.f, 0.f, 0.f, 0.f};
#pragma unroll
                for (int ks = 0; ks < 2; ++ks) {
                    const float* kr = kS + (16 * j + c16) * 68 + 32 * ks + 8 * q4; const float* br = bS + (16 * j + c16) * 68 + 32 * ks + 8 * q4;
                    const f32x4 k0 = *(const f32x4*)kr, k1 = *(const f32x4*)(kr + 4), b0 = *(const f32x4*)br, b1 = *(const f32x4*)(br + 4);
                    float kt[8];
                    kt[0] = k0.x * __expf(Bp[8 * ks + 0] - b0.x); kt[1] = k0.y * __expf(Bp[8 * ks + 1] - b0.y); kt[2] = k0.z * __expf(Bp[8 * ks + 2] - b0.z); kt[3] = k0.w * __expf(Bp[8 * ks + 3] - b0.w);
                    kt[4] = k1.x * __expf(Bp[8 * ks + 4] - b1.x); kt[5] = k1.y * __expf(Bp[8 * ks + 5] - b1.y); kt[6] = k1.z * __expf(Bp[8 * ks + 6] - b1.z); kt[7] = k1.w * __expf(Bp[8 * ks + 7] - b1.w);
                    z = MFMA16(pack8(kt), Qt[ks], z);
                }
#pragma unroll
                for (int r = 0; r < 4; ++r) pv[4 * hh + r] = z[r];
            } else {
#pragma unroll
                for (int r = 0; r < 4; ++r) pv[4 * hh + r] = 0.f;
            }
        }
        const bf16x8 P = pack8(pv);
#pragma unroll
        for (int et = 0; et < 4; ++et) accO[et] = MFMA16(vt_frag2(Vt, 16 * et + c16, 2 * pp, 2 * pp + 1, q4), P, accO[et]);
    }
    {
        float pd[8];
#pragma unroll
        for (int i = 0; i < 8; ++i) pd[i] = 0.f;
#pragma unroll
        for (int si = 0; si < 16; ++si) {
            const float* kr = kS + (16 * w + si) * 68 + 8 * q4; const float* br = bS + (16 * w + si) * 68 + 8 * q4;
            float v = 0.f;
#pragma unroll
            for (int ks = 0; ks < 2; ++ks) {
                const f32x4 k0 = *(const f32x4*)(kr + 32 * ks), k1 = *(const f32x4*)(kr + 32 * ks + 4), b0 = *(const f32x4*)(br + 32 * ks), b1 = *(const f32x4*)(br + 32 * ks + 4);
                v += qv[8 * ks + 0] * k0.x * __expf(fminf(bt[8 * ks + 0] - b0.x, 0.f)); v += qv[8 * ks + 1] * k0.y * __expf(fminf(bt[8 * ks + 1] - b0.y, 0.f));
                v += qv[8 * ks + 2] * k0.z * __expf(fminf(bt[8 * ks + 2] - b0.z, 0.f)); v += qv[8 * ks + 3] * k0.w * __expf(fminf(bt[8 * ks + 3] - b0.w, 0.f));
                v += qv[8 * ks + 4] * k1.x * __expf(fminf(bt[8 * ks + 4] - b1.x, 0.f)); v += qv[8 * ks + 5] * k1.y * __expf(fminf(bt[8 * ks + 5] - b1.y, 0.f));
                v += qv[8 * ks + 6] * k1.z * __expf(fminf(bt[8 * ks + 6] - b1.z, 0.f)); v += qv[8 * ks + 7] * k1.w * __expf(fminf(bt[8 * ks + 7] - b1.w, 0.f));
            }
            v += __shfl_xor(v, 16); v += __shfl_xor(v, 32);
            const float wv = (si <= c16) ? v : 0.f;
            if (q4 == (si >> 3)) pd[si & 7] = wv;
        }
        const bf16x8 P = pack8(pd);
        const bf16x8 zero8 = {0, 0, 0, 0, 0, 0, 0, 0};
#pragma unroll
        for (int et = 0; et < 4; ++et) {
            bf16x8 vf = zero8;
            if (q4 < 2) vf = *(const bf16x8*)(Vt + (16 * et + c16) * 136 + 16 * w + 8 * q4);
            accO[et] = MFMA16(vf, P, accO[et]);
        }
    }
    float ss = 0.f;
#pragma unroll
    for (int et = 0; et < 4; ++et)
#pragma unroll
        for (int r = 0; r < 4; ++r) ss += accO[et][r] * accO[et][r];
    ss += __shfl_xor(ss, 16); ss += __shfl_xor(ss, 32);
    const float rstd = 1.f / sqrtf(ss * (1.f / 64.f) + NORM_EPS);
    const float* ng = p.in[13] + l * GW + h * HD + 4 * q4;
    const bf16* gp = proj + (row0 + pos) * DIN + 12 * GW + h * HD + 4 * q4;
    bf16* yp = Y + (row0 + pos) * DM + 3 * GW + h * HD + 4 * q4;
#pragma unroll
    for (int et = 0; et < 4; ++et) {
        const f32x4 g4 = *(const f32x4*)(ng + 16 * et); const v2u gg = *(const v2u*)(gp + 16 * et);
        const float o0 = accO[et][0] * rstd * g4.x * siluf_(bflo(gg.x)), o1 = accO[et][1] * rstd * g4.y * siluf_(bfhi(gg.x));
        const float o2 = accO[et][2] * rstd * g4.z * siluf_(bflo(gg.y)), o3 = accO[et][3] * rstd * g4.w * siluf_(bfhi(gg.y));
        v2u o; o.x = pk2(o0, o1); o.y = pk2(o2, o3); *(v2u*)(yp + 16 * et) = o;
    }
}

template <int PASS>
__device__ __forceinline__ void mixer_a(unsigned char* lds, const Params& p, const bf16* proj, bf16* Y, int l, int item, int tid_in) {
    int tid = tid_in; asm volatile("" : "+v"(tid));
    const int lane = tid & 63, w = __builtin_amdgcn_readfirstlane(tid >> 6), c16 = lane & 15, q4 = lane >> 4;
    const int c = item & 31, bh = item >> 5, b = bh >> 2, h = bh & 3;
    const size_t row0 = (size_t)b * SEQ;
    bf16* Xs = (bf16*)(lds + L_KS); bf16* Wat = (bf16*)(lds + L_WAT); bf16* Wxt = (bf16*)(lds + L_WXT);
    float* aS = (float*)(lds + L_AS); float* uS = (float*)(lds + L_US); float* segA = (float*)(lds + L_SEGA); float* segH = (float*)(lds + L_SEGH);
    const int ch = tid & 63, blk = tid >> 6, col = h * HD + ch;
    __syncthreads();
    {
        const float* cwp = p.in[4] + (size_t)l * 4 * GW + col;
        const float cw0 = cwp[0], cw1 = cwp[GW], cw2 = cwp[2 * GW], cw3 = cwp[3 * GW], cb = p.in[5][l * GW + col];
        const int t0 = c * 128 + 16 * blk;
        const bf16* xp = proj + (row0 + t0) * DIN + col;
        float xm3 = (t0 >= 3) ? bf1(*(xp - 3 * (ptrdiff_t)DIN)) : 0.f, xm2 = (t0 >= 2) ? bf1(*(xp - 2 * (ptrdiff_t)DIN)) : 0.f, xm1 = (t0 >= 1) ? bf1(*(xp - (ptrdiff_t)DIN)) : 0.f;
#pragma unroll
        for (int i = 0; i < 16; ++i) {
            const float x = bf1(xp[(size_t)i * DIN]);
            const float xc = cb + cw0 * xm3 + cw1 * xm2 + cw2 * xm1 + cw3 * x;
            Xs[(16 * blk + i) * 72 + ch] = f2bf(xc);
            xm3 = xm2; xm2 = xm1; xm1 = x;
        }
        const float* wa = p.in[6] + (size_t)(l * NH + h) * 4096; const float* wx = p.in[8] + (size_t)(l * NH + h) * 4096;
#pragma unroll
        for (int k = 0; k < 8; ++k) { const int idx = tid + 512 * k, i = idx >> 6, j = idx & 63; Wat[j * 72 + i] = f2bf(wa[idx]); Wxt[j * 72 + i] = f2bf(wx[idx]); }
    }
    __syncthreads();
    {
        const bf16x8 x0 = *(const bf16x8*)(Xs + (16 * w + c16) * 72 + 8 * q4), x1 = *(const bf16x8*)(Xs + (16 * w + c16) * 72 + 32 + 8 * q4);
#pragma unroll
        for (int jt = 0; jt < 4; ++jt) {
            f32x4 ga = {0.f, 0.f, 0.f, 0.f}, gx = {0.f, 0.f, 0.f, 0.f};
            ga = MFMA16(x0, *(const bf16x8*)(Wat + (16 * jt + c16) * 72 + 8 * q4), ga); ga = MFMA16(x1, *(const bf16x8*)(Wat + (16 * jt + c16) * 72 + 32 + 8 * q4), ga);
            gx = MFMA16(x0, *(const bf16x8*)(Wxt + (16 * jt + c16) * 72 + 8 * q4), gx); gx = MFMA16(x1, *(const bf16x8*)(Wxt + (16 * jt + c16) * 72 + 32 + 8 * q4), gx);
            const int j = 16 * jt + c16, cj = l * GW + h * HD + j;
            const float ba = p.in[7][cj], bx = p.in[9][cj];
            const float lam = p.in[10][cj];
            const float lsl = -(fmaxf(-lam, 0.f) + log1pf(__expf(-fabsf(lam))));
#pragma unroll
            for (int r = 0; r < 4; ++r) {
                const int t = 16 * w + 4 * q4 + r;
                const float rr = sigmoidf_(ga[r] + ba), ii = sigmoidf_(gx[r] + bx);
                const float la = 8.f * rr * lsl;
                const float a = __expf(la), mult = sqrtf(fmaxf(-expm1f(2.f * la), 0.f));
                aS[t * 68 + j] = a; uS[t * 68 + j] = mult * ii * bf1(Xs[t * 72 + j]);
            }
        }
    }
    __syncthreads();
    {
        float As = 1.f, Hs = 0.f;
#pragma unroll
        for (int i = 0; i < 16; ++i) { const float a = aS[(16 * blk + i) * 68 + ch], u = uS[(16 * blk + i) * 68 + ch]; Hs = a * Hs + u; As *= a; }
        segA[blk * 64 + ch] = As; segH[blk * 64 + ch] = Hs;
    }
    __syncthreads();
    float* asum = (float*)(p.ws + WS_ASUM);
    if (PASS == 1) {
        if (blk == 7) {
            float A = 1.f, H = 0.f;
#pragma unroll
            for (int s = 0; s < 8; ++s) { const float sa = segA[s * 64 + ch]; H = sa * H + segH[s * 64 + ch]; A *= sa; }
            asum[((size_t)item * 64 + ch) * 2] = A; asum[((size_t)item * 64 + ch) * 2 + 1] = H;
        }
    } else {
        float hc = 0.f;
        for (int j = 0; j < c; ++j) { const float2 al = *(const float2*)(asum + ((size_t)(bh * 32 + j) * 64 + ch) * 2); hc = al.x * hc + al.y; }
        for (int s = 0; s < blk; ++s) hc = segA[s * 64 + ch] * hc + segH[s * 64 + ch];
        const int t0 = c * 128 + 16 * blk;
        const bf16* gp = proj + (row0 + t0) * DIN + GW + col;
        bf16* yp = Y + (row0 + t0) * DM + col;
#pragma unroll
        for (int i = 0; i < 16; ++i) {
            hc = aS[(16 * blk + i) * 68 + ch] * hc + uS[(16 * blk + i) * 68 + ch];
            yp[(size_t)i * DM] = f2bf(gelu_tanh_(bf1(gp[(size_t)i * DIN])) * hc);
        }
    }
}

typedef __attribute__((address_space(1))) unsigned gu32;
#define XB_TMO      128
#define XB_XCNT(j)  (256  + 64 * (j))
#define XB_XSUB(j)  (1280 + 64 * (j))
#define XB_XGEN(j)  (2304 + 64 * (j))
#define XB_TOP      3328
#define XB_TOPGEN   3392
#define XCD_BAR_WORDS 3456
#define XB_SPIN_CAP (1u << 18)

__device__ __forceinline__ unsigned xb_ld(unsigned* p)              { return __hip_atomic_load(p, __ATOMIC_RELAXED, __HIP_MEMORY_SCOPE_AGENT); }
__device__ __forceinline__ unsigned xb_add(unsigned* p, unsigned v) { return __hip_atomic_fetch_add(p, v, __ATOMIC_RELAXED, __HIP_MEMORY_SCOPE_AGENT); }
__device__ __forceinline__ unsigned xb_xcc_id() { return (unsigned)__builtin_amdgcn_s_getreg((3 << 11) | 20) & 0xFu; }
#define XB_SPIN(cond, bar) do { unsigned _sp = 0; while (cond) { __builtin_amdgcn_s_sleep(1); \
    if ((++_sp & 255u) == 0u) { if (xb_ld(&(bar)[XB_TMO])) break; if (_sp > XB_SPIN_CAP) { atomicAdd(&(bar)[XB_TMO], 1u); break; } } } } while (0)

struct XcdBarrier {
    unsigned* bar; unsigned x;
    volatile LAS unsigned* st;
};

__device__ __forceinline__ XcdBarrier xcd_barrier_post(unsigned* bar, volatile LAS unsigned* st) {
    XcdBarrier b; b.bar = bar; b.x = xb_xcc_id(); b.st = st;
    if (threadIdx.x == 0) (void)xb_add(&bar[XB_XCNT(b.x)], 1u);
    return b;
}
__device__ __forceinline__ void xcd_barrier_complete(unsigned* bar, unsigned x, unsigned& nloc, unsigned& nx) {
    const unsigned G = gridDim.x * gridDim.y * gridDim.z;
    unsigned sum, cnt, mine, sp = 0u;
    for (;;) {
        sum = 0u; cnt = 0u; mine = 0u;
#pragma unroll
        for (unsigned j = 0; j < 16; ++j) { const unsigned c = xb_ld(&bar[XB_XCNT(j)]); sum += c; cnt += (c > 0u) ? 1u : 0u; mine = (j == x) ? c : mine; }
        if (sum == G) break;
        __builtin_amdgcn_s_sleep(1);
        if ((++sp & 255u) == 0u) { if (xb_ld(&bar[XB_TMO])) break; if (sp > XB_SPIN_CAP) { atomicAdd(&bar[XB_TMO], 1u); break; } }
    }
    nloc = mine > 0u ? mine : 1u; nx = cnt > 0u ? cnt : 1u;
}

__device__ __forceinline__ void xcd_barrier(const XcdBarrier& b) {
    asm volatile("s_waitcnt vmcnt(0)" ::: "memory");
    __syncthreads();
    if (threadIdx.x == 0) {
        unsigned* bar = b.bar;
        __builtin_amdgcn_s_waitcnt(0);
        unsigned nloc = b.st[0], nx = b.st[1];
        if (nloc == 0u) { xcd_barrier_complete(bar, b.x, nloc, nx); b.st[0] = nloc; b.st[1] = nx; }
        const unsigned old = xb_add(&bar[XB_XSUB(b.x)], 1u);
        const unsigned gen = old / nloc;
        if (old + 1u == (gen + 1u) * nloc) {
            __builtin_amdgcn_fence(__ATOMIC_RELEASE, "agent");
            asm volatile("s_waitcnt vmcnt(0)" ::: "memory");
            const unsigned og = xb_add(&bar[XB_TOP], 1u);
            const unsigned tg = og / nx;
            if (og + 1u == (tg + 1u) * nx) xb_add(&bar[XB_TOPGEN], 1u);
            else XB_SPIN(xb_ld(&bar[XB_TOPGEN]) == tg, bar);
            __builtin_amdgcn_fence(__ATOMIC_ACQUIRE, "agent");
            xb_add(&bar[XB_XGEN(b.x)], 1u);
            asm volatile("s_waitcnt vmcnt(0)" ::: "memory");
        } else {
            XB_SPIN(xb_ld(&bar[XB_XGEN(b.x)]) == gen, bar);
            __builtin_amdgcn_fence(__ATOMIC_ACQUIRE, "agent");
            asm volatile("s_waitcnt vmcnt(0)" ::: "memory");
        }
    }
    __syncthreads();
}

__global__ void __launch_bounds__(512, 2) fwd_megakernel(Params p) {
    extern __shared__ __attribute__((aligned(16))) unsigned char lds[];
    cg::grid_group grid = cg::this_grid();
    const int G = gridDim.x;
    if (p.ws == nullptr) grid.sync();
    for (int u = threadIdx.x; u < 64; u += 512) ((volatile LAS unsigned*)((LAS unsigned char*)lds + 131072))[u] = 0u;
    __syncthreads();
    (void)xcd_barrier_post((unsigned*)(p.ws + WS_CTL) + CW_BAR, (volatile LAS unsigned*)((LAS unsigned char*)lds + 131072 + 32));
#define GRID_SYNC() do { XcdBarrier xb_; xb_.bar = (unsigned*)(p.ws + WS_CTL) + CW_BAR; xb_.x = xb_xcc_id(); xb_.st = (volatile LAS unsigned*)((LAS unsigned char*)lds + 131072 + 32); xcd_barrier(xb_); } while (0)
#define FRESH_TID() int tid = threadIdx.x; asm volatile("" : "+v"(tid)); const int lane = tid & 63, wave = tid >> 6, gw = blockIdx.x * 8 + wave, ngw = G * 8; (void)lane; (void)gw; (void)ngw;
    bf16* XN = (bf16*)(p.ws + WS_XN); bf16* PROJ = (bf16*)(p.ws + WS_PROJ); bf16* Y = (bf16*)(p.ws + WS_Y); bf16* U = (bf16*)(p.ws + WS_U);
    PG8_LAS unsigned char* glds = (PG8_LAS unsigned char*)lds;

    { FRESH_TID(); prologue(p, lds, tid); }
    GRID_SYNC();

    for (int l = 0; l < DEPTH; ++l) {
        const bf16* Wl = (const bf16*)(p.ws + WS_W + (size_t)l * W_LAYER_B);
        const bf16* Win_t = Wl; const bf16* Wout_t = Wl + (size_t)DIN * DM; const bf16* Wup_t = Wout_t + (size_t)DM * DM; const bf16* Wdn_t = Wup_t + (size_t)DFF * DM;
        {
            pg8::Gemm g{XN, Win_t, M, DIN, DM}; pg8::StaticOrder S; S.init(M, DIN, G, (int)blockIdx.x);
            pg8::EpiBf16<0> E{PROJ, DIN, nullptr, 0, 0, 1.f};
            pg8::gemm_phase<pg8::EpiBf16<0>, pg8::StaticOrder, true, true>(glds, g, S, E);
#ifdef MK_DUP_GEMM
            GRID_SYNC();
            pg8::gemm_phase<pg8::EpiBf16<0>, pg8::StaticOrder, true, true>(glds, g, S, E);
#endif
        }
        GRID_SYNC();
#if !defined(MK_SKELETON)
#ifdef MK_DUP_MIX
        for (int rep = 0; rep < 2; ++rep) {
#endif
        { FRESH_TID();
        for (int it = blockIdx.x; it < 3 * NITEM; it += G) {
            const int kind = it / NITEM, item = it % NITEM;
#ifndef MK_SKIP_D
            if (kind == 0) mixer_d_pass1(lds, p, PROJ, l, item, tid);
#endif
#ifndef MK_SKIP_B
            if (kind == 1) mixer_b_pass1(lds, p, PROJ, item, tid);
#endif
#ifndef MK_SKIP_A
            if (kind == 2) mixer_a<1>(lds, p, PROJ, Y, l, item, tid);
#endif
        } }
        GRID_SYNC();
        { FRESH_TID();
        for (int it = blockIdx.x; it < 4 * NITEM; it += G) {
            const int kind = it / NITEM, item = it % NITEM;
#ifndef MK_SKIP_C
            if (kind == 0) mixer_c_item(lds, PROJ, Y, item, tid);
#endif
#ifndef MK_SKIP_D
            if (kind == 1) mixer_d_pass2(lds, p, PROJ, Y, l, item, tid);
#endif
#ifndef MK_SKIP_B
            if (kind == 2) mixer_b_pass2(lds, p, PROJ, Y, l, item, tid);
#endif
#ifndef MK_SKIP_A
            if (kind == 3) mixer_a<2>(lds, p, PROJ, Y, l, item, tid);
#endif
        } }
        __syncthreads();
#ifdef MK_DUP_MIX
        if (rep == 0) GRID_SYNC();
        }
#endif
#else
        { FRESH_TID(); for (int m = gw; m < M; m += ngw) { const v4u* s = (const v4u*)(PROJ + (size_t)m * DIN); v4u* d = (v4u*)(Y + (size_t)m * DM); d[lane] = s[lane]; d[lane + 64] = s[lane + 64]; } }
#endif
        GRID_SYNC();
        {
            pg8::Gemm g{Y, Wout_t, M, DM, DM}; pg8::StaticOrder S; S.init(M, DM, G, (int)blockIdx.x);
            pg8::EpiRes E{p.out, DM, ALPHA};
            pg8::gemm_phase<pg8::EpiRes, pg8::StaticOrder, true, true>(glds, g, S, E);
        }
        GRID_SYNC();
        { FRESH_TID(); ln_phase(p.in[15] + l * DM, p.in[16] + l * DM, p.out, XN, gw, ngw, lane); }
        GRID_SYNC();
        {
            pg8::Gemm g{XN, Wup_t, M, DFF, DM}; pg8::StaticOrder S; S.init(M, DFF, G, (int)blockIdx.x);
            pg8::EpiBf16<2> E{U, DFF, nullptr, 0, 0, 1.f};
            pg8::gemm_phase<pg8::EpiBf16<2>, pg8::StaticOrder, true, true>(glds, g, S, E);
#ifdef MK_DUP_GEMM
            GRID_SYNC();
            pg8::gemm_phase<pg8::EpiBf16<2>, pg8::StaticOrder, true, true>(glds, g, S, E);
#endif
        }
        GRID_SYNC();
        {
            pg8::Gemm g{U, Wdn_t, M, DM, DFF}; pg8::StaticOrder S; S.init(M, DM, G, (int)blockIdx.x);
            pg8::EpiRes E{p.out, DM, ALPHA};
            pg8::gemm_phase<pg8::EpiRes, pg8::StaticOrder, true, true>(glds, g, S, E);
        }
        GRID_SYNC();
        { FRESH_TID(); ln_phase(p.in[19] + l * DM, p.in[20] + l * DM, p.out, XN, gw, ngw, lane); }
        if (l + 1 < DEPTH) GRID_SYNC();
    }
}

extern "C" void kernel_launch(void* const* d_in, const int* in_sizes, int n_in, void* d_out, int out_size, void* d_ws, size_t ws_size, hipStream_t stream) {
    static int grid_blocks = 0;
    if (grid_blocks == 0) {
        if (n_in != 21 || out_size != M * DM || ws_size < WS_END) { fprintf(stderr, "kernel_launch: unexpected shapes (n_in %d out %d ws %zu)\n", n_in, out_size, ws_size); grid_blocks = -1; return; }
        int dev = 0, cus = 0, per_cu = 0;
        hipGetDevice(&dev);
        hipDeviceGetAttribute(&cus, hipDeviceAttributeMultiprocessorCount, dev);
        if (hipFuncSetAttribute((const void*)fwd_megakernel, hipFuncAttributeMaxDynamicSharedMemorySize, LDS_BYTES) != hipSuccess) { fprintf(stderr, "kernel_launch: hipFuncSetAttribute failed\n"); grid_blocks = -1; return; }
        if (hipOccupancyMaxActiveBlocksPerMultiprocessor(&per_cu, (const void*)fwd_megakernel, 512, LDS_BYTES) != hipSuccess || per_cu < 1) { fprintf(stderr, "kernel_launch: occupancy query gave %d\n", per_cu); per_cu = 1; }
        (void)hipGetLastError();
        grid_blocks = cus * 1;
        if (per_cu < 1) grid_blocks = cus;
    }
    if (grid_blocks < 0) return;
    Params p{};
    for (int i = 0; i < 21; ++i) p.in[i] = (const float*)d_in[i];
    p.out = (float*)d_out; p.ws = (unsigned char*)d_ws;
    if (hipMemsetAsync((char*)d_ws + WS_CTL, 0, CTL_ZERO_BYTES, stream) != hipSuccess) { fprintf(stderr, "kernel_launch: hipMemsetAsync failed\n"); return; }
    void* args[] = {&p};
    hipError_t e = hipLaunchCooperativeKernel((const void*)fwd_megakernel, dim3(grid_blocks), dim3(512), args, LDS_BYTES, stream);
    if (e != hipSuccess) fprintf(stderr, "cooperative launch failed: %s (grid %d)\n", hipGetErrorString(e), grid_blocks);
}
```

```cpp
#include <hip/hip_runtime.h>
#include <hip/hip_cooperative_groups.h>
#include <cstdio>
#include <cstdint>
namespace cg = cooperative_groups;
namespace pg8 {
#define PG8_LAS __attribute__((address_space(3)))
typedef unsigned short bf16_t;
typedef short bf16x8 __attribute__((ext_vector_type(8)));
typedef float f32x4 __attribute__((ext_vector_type(4)));
typedef unsigned u32x4 __attribute__((ext_vector_type(4)));
constexpr int BM = 256, BK = 64, HALF = 128, HTB = HALF * BK * 2  , STAGE_BYTES = 8 * HTB, NXCD = 8, WGM = 8;

__host__ __device__ __forceinline__ int lds_byte(int r, int c) { const int st = (r >> 4) * 2 + (c >> 5), rr = r & 15, cc = c & 31, ob = rr * 64 + cc * 2; return st * 1024 + (ob ^ (((ob >> 9) & 1) << 5)); }
__host__ __device__ __forceinline__ void stage_rc(int b, int& R, int& C) { const int st = b / 1024, sb = b % 1024, swz = sb ^ (((sb >> 9) & 1) << 5); R = (st >> 1) * 16 + swz / 64; C = (st & 1) * 32 + (swz % 64) / 2; }
__host__ __device__ __forceinline__ int perm32(int rho) { const int n = rho >> 4, i = rho & 15; return 8 * (i >> 2) + 4 * n + (i & 3); }

struct Unit { int pm, pn; };
struct Gemm { const bf16_t* A; const bf16_t* Bt; int M, N, K; };

struct StaticOrder {
    int nM, nN, nwg, G, c;
    __host__ __device__ void init(int M, int N, int G_, int c_) { nM = M / BM; nN = N / BM; nwg = nM * nN; G = G_; c = c_; }
    __host__ __device__ bool next(int i, Unit& u) const {
        const long L = (long)i * G + c; if (L >= nwg) return false;
        int wgid = (int)L; { const int q = nwg / NXCD, r = nwg % NXCD, xcd = wgid % NXCD, off = wgid / NXCD; wgid = (xcd < r ? xcd * (q + 1) : r * (q + 1) + (xcd - r) * q) + off; }
        const int nig = WGM * nN, gid = wgid / nig, fm = gid * WGM, gsz = (nM - fm) < WGM ? (nM - fm) : WGM;
        u.pm = fm + ((wgid % nig) % gsz); u.pn = (wgid % nig) / gsz; return true;
    }
    __device__ __forceinline__ void a_ready(const Unit&) const {}
    __device__ __forceinline__ void done(const Unit&) const {}
};

__device__ __forceinline__ unsigned cvt_pk_bf16(float lo, float hi) { unsigned r; asm volatile("v_cvt_pk_bf16_f32 %0, %1, %2" : "=v"(r) : "v"(lo), "v"(hi)); return r; }
typedef float f32x2 __attribute__((ext_vector_type(2)));
__device__ __forceinline__ f32x2 gelu_pk(f32x2 v) {
    const f32x2 av = __builtin_elementwise_abs(v), d = av * 0.2316418882f + 1.0f;
    f32x2 t; t.x = __builtin_amdgcn_rcpf(d.x); t.y = __builtin_amdgcn_rcpf(d.y);
    f32x2 q = t * 0.5307027145f + (-0.7265760135f); q = q * t + 0.7107068705f; q = q * t + (-0.142248368f); q = q * t + 0.127414796f; q = q * t;
    const f32x2 s = (v * v) * (-0.72134752044f);
    f32x2 e; e.x = __builtin_amdgcn_exp2f(s.x); e.y = __builtin_amdgcn_exp2f(s.y);
    const f32x2 m = v * (q * e), r = v - m;
    f32x2 o; o.x = v.x < 0.f ? m.x : r.x; o.y = v.y < 0.f ? m.y : r.y; return o;
}

template <int ACT  > struct EpiBf16 {
    static constexpr bool PERM = true, AFTER_DRAIN = false; static_assert(ACT >= 0 && ACT <= 2, "EpiBf16: ACT is 0 (none), 1 (gelu_pk) or 2 (squared relu)");
    bf16_t* O; int ldc; const float* bias; int split_cols; size_t split_stride; float scale0;
    __device__ __forceinline__ void operator()(const f32x4 (&acc)[2][2][4][2], const Unit& u, int wr, int wc, int fr, int fq) const {
        const int row0 = u.pm * BM + wr * 64 + fr; int colt = u.pn * BM; bf16_t* base = O;
        float sc = 1.f; if (split_cols) { const int t = colt / split_cols; base += (size_t)t * split_stride; colt -= t * split_cols; if (t == 0) sc = scale0; }
        const int col0 = colt + wc * 32 + 8 * fq, bcol0 = u.pn * BM + wc * 32 + 8 * fq;
        f32x4 bv[2][2];
#pragma unroll
        for (int bj = 0; bj < 2; ++bj)
#pragma unroll
            for (int n = 0; n < 2; ++n) bv[bj][n] = bias ? *(const f32x4*)(bias + bcol0 + bj * HALF + 4 * n) : (f32x4){0.f, 0.f, 0.f, 0.f};
#pragma unroll
        for (int ai = 0; ai < 2; ++ai)
#pragma unroll
            for (int m = 0; m < 4; ++m) { bf16_t* rowp = base + (size_t)(row0 + ai * HALF + m * 16) * ldc + col0;
#pragma unroll
                for (int bj = 0; bj < 2; ++bj) { f32x4 v0 = acc[ai][bj][m][0] + bv[bj][0], v1 = acc[ai][bj][m][1] + bv[bj][1];
                    if (ACT == 1) { f32x2 a = gelu_pk((f32x2){v0[0], v0[1]}), b = gelu_pk((f32x2){v0[2], v0[3]}), c = gelu_pk((f32x2){v1[0], v1[1]}), d = gelu_pk((f32x2){v1[2], v1[3]});
                        v0 = (f32x4){a.x, a.y, b.x, b.y}; v1 = (f32x4){c.x, c.y, d.x, d.y}; }
                    if (ACT == 2) { v0 = __builtin_elementwise_max(v0, (f32x4){0.f, 0.f, 0.f, 0.f}); v1 = __builtin_elementwise_max(v1, (f32x4){0.f, 0.f, 0.f, 0.f}); v0 = v0 * v0; v1 = v1 * v1; }
                    v0 = v0 * sc; v1 = v1 * sc; u32x4 w; w.x = cvt_pk_bf16(v0[0], v0[1]); w.y = cvt_pk_bf16(v0[2], v0[3]); w.z = cvt_pk_bf16(v1[0], v1[1]); w.w = cvt_pk_bf16(v1[2], v1[3]);
                    *(u32x4*)(rowp + bj * HALF) = w; } }
    }
};

struct PanelStats {
    unsigned* xbuf;
    unsigned* cnt;
    unsigned* tmo;
    int ntn; float eps;
    unsigned code;
    __device__ __forceinline__ bool run(const f32x4 (&v)[2][2][4][2], const Unit& u, int wr, int wc, int fr, int fq, PG8_LAS unsigned char* lds, int wid, int lane) const {
        typedef float f32x2v __attribute__((ext_vector_type(2)));
        PG8_LAS f32x2v* P = (PG8_LAS f32x2v*)lds;
        PG8_LAS f32x2v* S = (PG8_LAS f32x2v*)(lds + 8192);
        PG8_LAS unsigned* flag = (PG8_LAS unsigned*)(lds + 8192 + 2048);
#pragma unroll
        for (int ai = 0; ai < 2; ++ai)
#pragma unroll
            for (int m = 0; m < 4; ++m) {
                float s = 0.f;
#pragma unroll
                for (int bj = 0; bj < 2; ++bj)
#pragma unroll
                    for (int n = 0; n < 2; ++n) { const f32x4 x = v[ai][bj][m][n]; s += (x[0] + x[1]) + (x[2] + x[3]); }
                s += __shfl_xor(s, 16); s += __shfl_xor(s, 32);
                const float mw = s * (1.0f / 64.0f); float q = 0.f;
#pragma unroll
                for (int bj = 0; bj < 2; ++bj)
#pragma unroll
                    for (int n = 0; n < 2; ++n) { const f32x4 d = v[ai][bj][m][n] - mw; q += (d[0] * d[0] + d[1] * d[1]) + (d[2] * d[2] + d[3] * d[3]); }
                q += __shfl_xor(q, 16); q += __shfl_xor(q, 32);
                if (fq == 0) P[(ai * HALF + wr * 64 + m * 16 + fr) * 4 + wc] = (f32x2v){mw, q};
            }
        asm volatile("s_waitcnt lgkmcnt(0)" ::: "memory"); __builtin_amdgcn_s_barrier(); asm volatile("" ::: "memory");
#if defined(BROKEN_EXCHANGE_NO_WAIT)
#warning BROKEN CONTROL BUILD: the row-statistics exchange does not wait; results are wrong by design
        if (blockIdx.x >= 64) { const long long t0_ = clock64(); while (clock64() - t0_ < 60000) __builtin_amdgcn_s_sleep(8); }
#endif
        const int row = wid * 32 + (lane & 31);
        if (lane < 32) {
            const f32x2v a = P[row * 4 + 0], b = P[row * 4 + 1], c = P[row * 4 + 2], d = P[row * 4 + 3];
            const float mt = (a.x + b.x + c.x + d.x) * 0.25f;
            const float da = a.x - mt, db = b.x - mt, dc = c.x - mt, dd = d.x - mt;
            const float m2 = (a.y + b.y) + (c.y + d.y) + 64.0f * ((da * da + db * db) + (dc * dc + dd * dd));
            unsigned long long* slot = (unsigned long long*)xbuf + ((size_t)(u.pm * BM + row) * 4 + u.pn);
            __hip_atomic_store(slot, ((unsigned long long)__float_as_uint(m2) << 32) | __float_as_uint(mt), __ATOMIC_RELAXED, __HIP_MEMORY_SCOPE_AGENT);
        }
        asm volatile("s_waitcnt vmcnt(0)" ::: "memory");
        if (lane == 0) __hip_atomic_fetch_add(cnt + 64 * u.pm, 1u, __ATOMIC_RELAXED, __HIP_MEMORY_SCOPE_AGENT);
        if (wid == 0) {
            bool dead = false; const unsigned long long t0 = __builtin_amdgcn_s_memrealtime(); const unsigned want = 8u * (unsigned)ntn;
            for (;;) {
#if defined(BROKEN_EXCHANGE_NO_WAIT)
                break;
#endif
                if ((unsigned)__builtin_amdgcn_readfirstlane(__hip_atomic_load(cnt + 64 * u.pm, __ATOMIC_RELAXED, __HIP_MEMORY_SCOPE_AGENT)) >= want) break;
                if (__builtin_amdgcn_s_memrealtime() - t0 > 2000000ull) {
                    if (lane == 0) { unsigned expect = 0u; __hip_atomic_compare_exchange_strong(tmo + 1, &expect, code | (unsigned)(u.pm & 0xff), __ATOMIC_RELAXED, __ATOMIC_RELAXED, __HIP_MEMORY_SCOPE_AGENT);
                                     __hip_atomic_store(tmo, 1u, __ATOMIC_RELAXED, __HIP_MEMORY_SCOPE_AGENT); }
                    dead = true; break; }
                __builtin_amdgcn_s_sleep(2);
            }
            __builtin_amdgcn_fence(__ATOMIC_ACQUIRE, "agent");
            if (lane == 0) flag[0] = dead ? 1u : 0u;
        }
        asm volatile("s_waitcnt vmcnt(0) lgkmcnt(0)" ::: "memory"); __builtin_amdgcn_s_barrier(); asm volatile("" ::: "memory");
        const bool bad = flag[0] != 0u;
        if (lane < 32) {
            const unsigned long long* slot = (const unsigned long long*)xbuf + (size_t)(u.pm * BM + row) * 4; float mt[4], m2[4]; float ms = 0.f;
#pragma unroll
            for (int t = 0; t < 4; ++t) { if (t < ntn) { const unsigned long long w = __hip_atomic_load(slot + t, __ATOMIC_RELAXED, __HIP_MEMORY_SCOPE_AGENT); mt[t] = __uint_as_float((unsigned)w); m2[t] = __uint_as_float((unsigned)(w >> 32)); } else { mt[t] = 0.f; m2[t] = 0.f; } ms += mt[t]; }
            const float mean = ms / (float)ntn; float q = 0.f;
#pragma unroll
            for (int t = 0; t < 4; ++t) if (t < ntn) { const float dm = mt[t] - mean; q += m2[t] + 256.0f * dm * dm; }
            S[row] = (f32x2v){mean, 1.0f / sqrtf(q / (256.0f * (float)ntn) + eps)};
        }
        asm volatile("s_waitcnt lgkmcnt(0)" ::: "memory"); __builtin_amdgcn_s_barrier(); asm volatile("" ::: "memory");
        return bad;
    }
};
struct EpiLnRes {
    static constexpr bool PERM = false, AFTER_DRAIN = true;
    const float* base; float* out; int ldc; const float* bias; PanelStats st; unsigned poison;
    __device__ __forceinline__ void fused(f32x4 (&acc)[2][2][4][2], const Unit& u, int wr, int wc, int fr, int fq, PG8_LAS unsigned char* lds, int wid, int lane) const {
        typedef float f32x2v __attribute__((ext_vector_type(2)));
        const PG8_LAS f32x2v* S = (const PG8_LAS f32x2v*)(lds + 8192);
        const int col0 = u.pn * BM + wc * 32 + 4 * fq;
#pragma unroll
        for (int bj = 0; bj < 2; ++bj)
#pragma unroll
            for (int n = 0; n < 2; ++n) { const f32x4 bv = bias ? *(const f32x4*)(bias + col0 + bj * HALF + n * 16) : (f32x4){0.f, 0.f, 0.f, 0.f};
#pragma unroll
                for (int ai = 0; ai < 2; ++ai)
#pragma unroll
                    for (int m = 0; m < 4; ++m) acc[ai][bj][m][n] += bv; }
        f32x4 pre[4][2][2];
#pragma unroll
        for (int m = 0; m < 4; ++m) { const size_t off = (size_t)(u.pm * BM + wr * 64 + m * 16 + fr) * ldc + col0;
#pragma unroll
            for (int bj = 0; bj < 2; ++bj)
#pragma unroll
                for (int n = 0; n < 2; ++n) pre[m][bj][n] = *(const f32x4*)(base + off + bj * HALF + n * 16); }
        const bool bad = st.run(acc, u, wr, wc, fr, fq, lds, wid, lane) || poison != 0u;
        const float qnan = __builtin_nanf("");
#pragma unroll
        for (int ai = 0; ai < 2; ++ai)
#pragma unroll
            for (int m = 0; m < 4; ++m) { const int r = ai * HALF + wr * 64 + m * 16 + fr; const f32x2v sr = S[r]; const size_t off = (size_t)(u.pm * BM + r) * ldc + col0;
#pragma unroll
                for (int bj = 0; bj < 2; ++bj)
#pragma unroll
                    for (int n = 0; n < 2; ++n) { const f32x4 bs = ai == 0 ? pre[m][bj][n] : *(const f32x4*)(base + off + bj * HALF + n * 16); f32x4 o = bs + (acc[ai][bj][m][n] - sr.x) * sr.y;
                        if (bad) o = (f32x4){qnan, qnan, qnan, qnan}; *(f32x4*)(out + off + bj * HALF + n * 16) = o; }
                if (m & 1) asm volatile("" ::: "memory"); }
    }
};
struct EpiLnResLn {
    static constexpr bool PERM = false, AFTER_DRAIN = true;
    const float* base; float* out; bf16_t* xn; int ldc; const float* bias; PanelStats st1, st2; unsigned poison;
    __device__ __forceinline__ void fused(f32x4 (&acc)[2][2][4][2], const Unit& u, int wr, int wc, int fr, int fq, PG8_LAS unsigned char* lds, int wid, int lane) const {
        typedef float f32x2v __attribute__((ext_vector_type(2))); typedef unsigned u32x2v __attribute__((ext_vector_type(2)));
        const PG8_LAS f32x2v* S = (const PG8_LAS f32x2v*)(lds + 8192);
        const int col0 = u.pn * BM + wc * 32 + 4 * fq;
#pragma unroll
        for (int bj = 0; bj < 2; ++bj)
#pragma unroll
            for (int n = 0; n < 2; ++n) { const f32x4 bv = bias ? *(const f32x4*)(bias + col0 + bj * HALF + n * 16) : (f32x4){0.f, 0.f, 0.f, 0.f};
#pragma unroll
                for (int ai = 0; ai < 2; ++ai)
#pragma unroll
                    for (int m = 0; m < 4; ++m) acc[ai][bj][m][n] += bv; }
        bool bad = st1.run(acc, u, wr, wc, fr, fq, lds, wid, lane) || poison != 0u;
        const float qnan = __builtin_nanf("");
#pragma unroll
        for (int ai = 0; ai < 2; ++ai)
#pragma unroll
            for (int m = 0; m < 4; ++m) { const int r = ai * HALF + wr * 64 + m * 16 + fr; const f32x2v sr = S[r]; const size_t off = (size_t)(u.pm * BM + r) * ldc + col0;
#pragma unroll
                for (int bj = 0; bj < 2; ++bj)
#pragma unroll
                    for (int n = 0; n < 2; ++n) { const f32x4 bs = *(const f32x4*)(base + off + bj * HALF + n * 16); acc[ai][bj][m][n] = bs + (acc[ai][bj][m][n] - sr.x) * sr.y; }
                asm volatile("" : "+v"(acc[ai][0][m][0]), "+v"(acc[ai][0][m][1]), "+v"(acc[ai][1][m][0]), "+v"(acc[ai][1][m][1]));
                if (m & 1) asm volatile("" ::: "memory"); }
        const bool bad1 = bad;
        bad = st2.run(acc, u, wr, wc, fr, fq, lds, wid, lane) || bad;
#pragma unroll
        for (int ai = 0; ai < 2; ++ai)
#pragma unroll
            for (int m = 0; m < 4; ++m) { const int r = ai * HALF + wr * 64 + m * 16 + fr; const f32x2v sr = S[r]; const size_t off = (size_t)(u.pm * BM + r) * ldc + col0;
#pragma unroll
                for (int bj = 0; bj < 2; ++bj)
#pragma unroll
                    for (int n = 0; n < 2; ++n) { const f32x4 x1 = acc[ai][bj][m][n]; *(f32x4*)(out + off + bj * HALF + n * 16) = bad1 ? (f32x4){qnan, qnan, qnan, qnan} : x1;
                        const f32x4 o = (x1 - sr.x) * sr.y; u32x2v w; w.x = cvt_pk_bf16(o[0], o[1]); w.y = cvt_pk_bf16(o[2], o[3]);
                        if (bad) { w.x = 0x7fc07fc0u; w.y = 0x7fc07fc0u; } *(u32x2v*)(xn + off + bj * HALF + n * 16) = w; }
                asm volatile("" ::: "memory"); }
    }
};

template <class Epi, class Sched, bool ALIGN_EPI = false, bool SP2 = false>
__device__ __forceinline__ void gemm_phase(PG8_LAS unsigned char* lds, const Gemm g, const Sched& S, const Epi& E) {
    int tid_l = threadIdx.x; asm volatile("" : "+v"(tid_l)); const int tid = tid_l, wid = __builtin_amdgcn_readfirstlane(tid >> 6), lane = tid & 63, wr = wid >> 2, wc = wid & 3, fr = lane & 15, fq = lane >> 4;
    const int K = g.K, nt = K / BK;
    unsigned voffA[2], voffB[2];
#pragma unroll
    for (int i = 0; i < 2; ++i) { int R, C; stage_rc(tid * 16 + i * 8192, R, C); const int Rb = Epi::PERM ? ((R & ~31) + perm32(R & 31)) : R;
        voffA[i] = (unsigned)(R * K + C) * 2u; voffB[i] = (unsigned)(Rb * K + C) * 2u; }
    const size_t kstep = (size_t)(BK * 2);
    const size_t hstep = (size_t)HALF * K * 2;
    const size_t tstep = 2 * hstep;
    const unsigned ldsw = (unsigned)wid * 1024u;
    const int aoff = lds_byte(wr * 64 + fr, fq * 8), boff = lds_byte(wc * 32 + fr, fq * 8);
#define PG8_SA(b, h) (((b) * 2 + (h)) * HTB)
#define PG8_SB(b, h) ((4 + (b) * 2 + (h)) * HTB)
#define PG8_STAGE(bufoff, gbase, voff) do { _Pragma("unroll") for (int _i = 0; _i < 2; ++_i) \
        __builtin_amdgcn_global_load_lds((const unsigned*)((const char*)(gbase) + (voff)[_i]), (PG8_LAS unsigned*)(lds + (bufoff) + ldsw + _i * 8192), 16, 0, 0); } while (0)
#define PG8_LDA(dst, b, h) do { _Pragma("unroll") for (int m = 0; m < 4; ++m) _Pragma("unroll") for (int k = 0; k < 2; ++k) dst[m][k] = *(const PG8_LAS bf16x8*)(lds + PG8_SA(b, h) + aoff + m * 2048 + k * 1024); } while (0)
#define PG8_LDB(dst, b, h) do { _Pragma("unroll") for (int n = 0; n < 2; ++n) _Pragma("unroll") for (int k = 0; k < 2; ++k) dst[n][k] = *(const PG8_LAS bf16x8*)(lds + PG8_SB(b, h) + boff + n * 2048 + k * 1024); } while (0)
#define PG8_MMA(ai, bj, At, Bt) do { __builtin_amdgcn_s_setprio(1); _Pragma("unroll") for (int m = 0; m < 4; ++m) _Pragma("unroll") for (int n = 0; n < 2; ++n) _Pragma("unroll") for (int k = 0; k < 2; ++k) \
        acc[ai][bj][m][n] = __builtin_amdgcn_mfma_f32_16x16x32_bf16(Bt[n][k], At[m][k], acc[ai][bj][m][n], 0, 0, 0); __builtin_amdgcn_s_setprio(0); } while (0)
#define PG8_WAIT_V(n) asm volatile("s_waitcnt vmcnt(" #n ")" ::: "memory")
#define PG8_WAIT_L(n) asm volatile("s_waitcnt lgkmcnt(" #n ")" ::: "memory")
#define PG8_BAR __builtin_amdgcn_s_barrier()
#define PG8_SCHED __builtin_amdgcn_sched_barrier(0)
    Unit cur, nxt; int ui = 0;
    if (!S.next(0, cur)) return;
    f32x4 acc[2][2][4][2];
#pragma unroll
    for (int a = 0; a < 2; ++a)
#pragma unroll
        for (int b = 0; b < 2; ++b)
#pragma unroll
            for (int m = 0; m < 4; ++m)
#pragma unroll
                for (int n = 0; n < 2; ++n) acc[a][b][m][n] = (f32x4){0.f, 0.f, 0.f, 0.f};
    bf16x8 At[4][2], B0[2][2], B1[2][2];
    const char* cA = (const char*)g.A + (size_t)cur.pm * tstep; const char* cB = (const char*)g.Bt + (size_t)cur.pn * tstep;
    S.a_ready(cur);
    if constexpr (SP2) {
        PG8_STAGE(PG8_SB(0, 0), cB, voffB); PG8_STAGE(PG8_SB(0, 1), cB + hstep, voffB); PG8_STAGE(PG8_SA(0, 0), cA, voffA); PG8_STAGE(PG8_SA(0, 1), cA + hstep, voffA);
        if (wr == 1) PG8_BAR;
        PG8_WAIT_V(2); PG8_BAR;
        PG8_STAGE(PG8_SB(1, 0), cB + kstep, voffB); PG8_STAGE(PG8_SA(1, 0), cA + kstep, voffA); PG8_STAGE(PG8_SB(1, 1), cB + hstep + kstep, voffB);
        PG8_WAIT_V(6); PG8_BAR;
    } else {
        PG8_STAGE(PG8_SB(0, 0), cB, voffB); PG8_STAGE(PG8_SA(0, 0), cA, voffA); PG8_STAGE(PG8_SB(0, 1), cB + hstep, voffB); PG8_STAGE(PG8_SA(0, 1), cA + hstep, voffA);
        if (wr == 1) PG8_BAR;
        PG8_WAIT_V(4); PG8_BAR;
        PG8_STAGE(PG8_SB(1, 0), cB + kstep, voffB); PG8_STAGE(PG8_SA(1, 0), cA + kstep, voffA); PG8_STAGE(PG8_SB(1, 1), cB + hstep + kstep, voffB);
        PG8_WAIT_V(6); PG8_BAR;
    }
    for (;;) {
        const bool has_next = S.next(ui + 1, nxt);
        const char* nA = has_next ? (const char*)g.A + (size_t)nxt.pm * tstep : cA; const char* nB = has_next ? (const char*)g.Bt + (size_t)nxt.pn * tstep : cB;
        for (int t = 0; t < nt; t += 2) {
            const bool last = (t == nt - 2);
            const char* a1 = cA + (size_t)(t + 1) * kstep;
            const char* a2 = last ? nA : cA + (size_t)(t + 2) * kstep; const char* b2 = last ? nB : cB + (size_t)(t + 2) * kstep;
            const char* a3 = a2 + kstep; const char* b3 = b2 + kstep;
            if (last && has_next) S.a_ready(nxt);
            if constexpr (SP2) {
            PG8_LDB(B0, 0, 0); PG8_LDB(B1, 0, 1); PG8_SCHED; PG8_LDA(At, 0, 0); PG8_STAGE(PG8_SA(1, 1), a1 + hstep, voffA);
            PG8_WAIT_V(8); PG8_WAIT_L(0); PG8_BAR; PG8_MMA(0, 0, At, B0); PG8_MMA(0, 1, At, B1); PG8_BAR; PG8_SCHED;
            PG8_LDA(At, 0, 1); PG8_STAGE(PG8_SB(0, 0), b2, voffB); PG8_STAGE(PG8_SB(0, 1), b2 + hstep, voffB); PG8_STAGE(PG8_SA(0, 0), a2, voffA);
            PG8_WAIT_V(8); PG8_WAIT_L(0); PG8_BAR; PG8_MMA(1, 0, At, B0); PG8_MMA(1, 1, At, B1); PG8_BAR; PG8_SCHED;
            PG8_LDB(B0, 1, 0); PG8_LDB(B1, 1, 1); PG8_SCHED; PG8_LDA(At, 1, 0); PG8_STAGE(PG8_SA(0, 1), a2 + hstep, voffA);
            PG8_WAIT_V(8); PG8_WAIT_L(0); PG8_BAR; PG8_MMA(0, 0, At, B0); PG8_MMA(0, 1, At, B1); PG8_BAR; PG8_SCHED;
            PG8_LDA(At, 1, 1); PG8_STAGE(PG8_SB(1, 0), b3, voffB); PG8_STAGE(PG8_SB(1, 1), b3 + hstep, voffB); PG8_STAGE(PG8_SA(1, 0), a3, voffA);
            PG8_WAIT_V(8); PG8_WAIT_L(0); PG8_BAR; PG8_MMA(1, 0, At, B0); PG8_MMA(1, 1, At, B1); PG8_BAR; PG8_SCHED;
            } else {
            PG8_LDB(B0, 0, 0); PG8_SCHED; PG8_LDA(At, 0, 0); PG8_STAGE(PG8_SA(1, 1), a1 + hstep, voffA);
            PG8_WAIT_L(8); PG8_BAR; PG8_WAIT_L(0); PG8_MMA(0, 0, At, B0); PG8_BAR; PG8_SCHED;
            PG8_LDB(B1, 0, 1); PG8_STAGE(PG8_SB(0, 0), b2, voffB);
            PG8_BAR; PG8_WAIT_L(0); PG8_MMA(0, 1, At, B1); PG8_BAR;
            PG8_LDA(At, 0, 1); PG8_STAGE(PG8_SA(0, 0), a2, voffA);
            PG8_BAR; PG8_WAIT_L(0); PG8_MMA(1, 0, At, B0); PG8_BAR; PG8_SCHED;
            PG8_STAGE(PG8_SB(0, 1), b2 + hstep, voffB);
            PG8_WAIT_V(6); PG8_BAR; PG8_MMA(1, 1, At, B1); PG8_BAR;
            PG8_LDB(B0, 1, 0); PG8_SCHED; PG8_LDA(At, 1, 0); PG8_STAGE(PG8_SA(0, 1), a2 + hstep, voffA);
            PG8_WAIT_L(8); PG8_BAR; PG8_WAIT_L(0); PG8_MMA(0, 0, At, B0); PG8_BAR; PG8_SCHED;
            PG8_LDB(B1, 1, 1); PG8_STAGE(PG8_SB(1, 0), b3, voffB);
            PG8_BAR; PG8_WAIT_L(0); PG8_MMA(0, 1, At, B1); PG8_BAR;
            PG8_LDA(At, 1, 1); PG8_STAGE(PG8_SA(1, 0), a3, voffA);
            PG8_BAR; PG8_WAIT_L(0); PG8_MMA(1, 0, At, B0); PG8_BAR; PG8_SCHED;
            PG8_STAGE(PG8_SB(1, 1), b3 + hstep, voffB);
            PG8_WAIT_V(6); PG8_BAR; PG8_MMA(1, 1, At, B1); PG8_BAR;
            }
        }
        if constexpr (ALIGN_EPI) { if (wr == 0) PG8_BAR; }
        if constexpr (!Epi::AFTER_DRAIN) { E(acc, cur, wr, wc, fr, fq); S.done(cur); }
        if (!has_next) break;
#pragma unroll
        for (int a = 0; a < 2; ++a)
#pragma unroll
            for (int b = 0; b < 2; ++b)
#pragma unroll
                for (int m = 0; m < 4; ++m)
#pragma unroll
                    for (int n = 0; n < 2; ++n) acc[a][b][m][n] = (f32x4){0.f, 0.f, 0.f, 0.f};
        cur = nxt; cA = nA; cB = nB; ++ui;
        if constexpr (ALIGN_EPI) { if (wr == 1) PG8_BAR; }
    }
    PG8_WAIT_V(0);
    if constexpr (!ALIGN_EPI) { if (wr == 0) PG8_BAR; }
    PG8_BAR;
    if constexpr (Epi::AFTER_DRAIN) { E.fused(acc, cur, wr, wc, fr, fq, lds, wid, lane); S.done(cur); }
#undef PG8_SA
#undef PG8_SB
#undef PG8_STAGE
#undef PG8_LDA
#undef PG8_LDB
#undef PG8_MMA
#undef PG8_WAIT_V
#undef PG8_WAIT_L
#undef PG8_BAR
#undef PG8_SCHED
}
}

namespace pg8 {
struct EpiRes {
    static constexpr bool PERM = false, AFTER_DRAIN = false;
    float* io; int ldc; float alpha;
    __device__ __forceinline__ void operator()(const f32x4 (&acc)[2][2][4][2], const Unit& u, int wr, int wc, int fr, int fq) const {
        const int col0 = u.pn * BM + wc * 32 + 4 * fq;
#pragma unroll
        for (int ai = 0; ai < 2; ++ai)
#pragma unroll
            for (int m = 0; m < 4; ++m) { float* rp = io + (size_t)(u.pm * BM + ai * HALF + wr * 64 + m * 16 + fr) * ldc + col0;
#pragma unroll
                for (int bj = 0; bj < 2; ++bj)
#pragma unroll
                    for (int n = 0; n < 2; ++n) { f32x4* p = (f32x4*)(rp + bj * HALF + n * 16); const f32x4 o = *p; *p = o * alpha + acc[ai][bj][m][n]; } }
    }
};
}

constexpr int BATCH = 4, SEQ = 4096, DM = 1024, DEPTH = 2, HD = 64, GW = 256, NH = 4, DIN = 3328, DFF = 4096, M = BATCH * SEQ;
constexpr float LN_EPS = 1e-5f, NORM_EPS = 1e-6f;
constexpr float ALPHA = 1.41421356237309515f;
constexpr int NCH = SEQ / 128;
constexpr int NITEM = BATCH * NH * NCH;

constexpr size_t MiB = 1u << 20;
constexpr size_t W_IN_B = (size_t)DIN * DM * 2, W_OUT_B = (size_t)DM * DM * 2, W_UP_B = (size_t)DFF * DM * 2, W_DN_B = (size_t)DM * DFF * 2;
constexpr size_t W_LAYER_B = W_IN_B + W_OUT_B + W_UP_B + W_DN_B;
constexpr size_t WS_W = 0;
constexpr size_t WS_CTL = 50 * MiB, CTL_ZERO_BYTES = 1 * MiB;
constexpr int CW_BAR = 4096;
constexpr size_t WS_XN = 52 * MiB;
constexpr size_t WS_PROJ = 84 * MiB;
constexpr size_t WS_Y = 188 * MiB;
constexpr size_t WS_U = 84 * MiB;
constexpr size_t WS_KVB = 220 * MiB;
constexpr size_t WS_KVD = 228 * MiB;
constexpr size_t WS_DVEC = 236 * MiB;
constexpr size_t WS_ASUM = 236 * MiB + 256 * 1024;
constexpr size_t WS_LB = 236 * MiB + 768 * 1024;
constexpr size_t WS_ROPE = 237 * MiB;
constexpr size_t WS_END = 238 * MiB;
static_assert(2 * W_LAYER_B <= WS_XN, "weights fit");

constexpr int LDS_BYTES = 147456;

typedef unsigned short bf16;
typedef unsigned v4u __attribute__((ext_vector_type(4)));
typedef unsigned v2u __attribute__((ext_vector_type(2)));
typedef float f32x4 __attribute__((ext_vector_type(4)));
typedef short bf16x8 __attribute__((ext_vector_type(8)));
#define LAS __attribute__((address_space(3)))
#define MFMA16(a, b, c) __builtin_amdgcn_mfma_f32_16x16x32_bf16((a), (b), (c), 0, 0, 0)

typedef float f32x2_ __attribute__((ext_vector_type(2)));
typedef __bf16 bf16x2_ __attribute__((ext_vector_type(2)));
__device__ __forceinline__ unsigned pk2(float lo, float hi) { f32x2_ v = {lo, hi}; bf16x2_ b = __builtin_convertvector(v, bf16x2_); return __builtin_bit_cast(unsigned, b); }
__device__ __forceinline__ float bflo(unsigned u) { return __uint_as_float(u << 16); }
__device__ __forceinline__ float bfhi(unsigned u) { return __uint_as_float(u & 0xffff0000u); }
__device__ __forceinline__ float bf1(bf16 u) { return __uint_as_float(((unsigned)u) << 16); }
__device__ __forceinline__ bf16 f2bf(float f) { return (bf16)(pk2(f, 0.f) & 0xffffu); }
__device__ __forceinline__ bf16x8 pack8(const float (&v)[8]) {
    v4u w; w.x = pk2(v[0], v[1]); w.y = pk2(v[2], v[3]); w.z = pk2(v[4], v[5]); w.w = pk2(v[6], v[7]);
    return __builtin_bit_cast(bf16x8, w);
}
__device__ __forceinline__ void unpack8(v4u w, float (&v)[8]) {
    v[0] = bflo(w.x); v[1] = bfhi(w.x); v[2] = bflo(w.y); v[3] = bfhi(w.y); v[4] = bflo(w.z); v[5] = bfhi(w.z); v[6] = bflo(w.w); v[7] = bfhi(w.w);
}
__device__ __forceinline__ float wave_sum(float v) {
#pragma unroll
    for (int o = 1; o < 64; o <<= 1) v += __shfl_xor(v, o);
    return v;
}
__device__ __forceinline__ float sigmoidf_(float x) { return __builtin_amdgcn_rcpf(1.f + __expf(-x)); }
__device__ __forceinline__ float siluf_(float x) { return x * sigmoidf_(x); }
__device__ __forceinline__ float gelu_tanh_(float x) { const float u = 0.7978845608028654f * (x + 0.044715f * x * x * x); const float t = 1.f - 2.f * __builtin_amdgcn_rcpf(1.f + __expf(2.f * u)); return 0.5f * x * (1.f + t); }
__device__ __forceinline__ float softplusf_(float z) { return fmaxf(z, 0.f) + __logf(1.f + __expf(-fabsf(z))); }

struct Params {
    const float* in[21];
    float* out;
    unsigned char* ws;
};

__device__ __forceinline__ void p0_transpose_item(const float* W, int K, int N, bf16* WT, float* scr, int item, int lane) {
    const int nblk = N / 32, kb = item / nblk, nb = item % nblk, k0 = 64 * kb, n0 = 32 * nb;
#pragma unroll 8
    for (int i = 0; i < 32; ++i) { const int kk = 2 * i + (lane >> 5); scr[kk * 33 + (lane & 31)] = W[(size_t)(k0 + kk) * N + n0 + (lane & 31)]; }
    asm volatile("s_waitcnt lgkmcnt(0)" ::: "memory");
    const int c = lane & 7;
#pragma unroll
    for (int j = 0; j < 4; ++j) { const int n = (lane >> 3) + 8 * j; const float* s = scr + (8 * c) * 33 + n;
        v4u o; o.x = pk2(s[0 * 33], s[1 * 33]); o.y = pk2(s[2 * 33], s[3 * 33]); o.z = pk2(s[4 * 33], s[5 * 33]); o.w = pk2(s[6 * 33], s[7 * 33]);
        *(v4u*)(WT + (size_t)(n0 + n) * K + k0 + 8 * c) = o; }
    asm volatile("s_waitcnt lgkmcnt(0)" ::: "memory");
}
__device__ __forceinline__ void ln_row(const float* src, const float* g, const float* b, float* dstf, bf16* dstb, int lane) {
    const f32x4* xr = (const f32x4*)src + lane;
    f32x4 v[4]; float s = 0.f;
#pragma unroll
    for (int j = 0; j < 4; ++j) { v[j] = xr[64 * j]; s += (v[j].x + v[j].y) + (v[j].z + v[j].w); }
    const float mean = wave_sum(s) * (1.f / DM); float s2 = 0.f;
#pragma unroll
    for (int j = 0; j < 4; ++j) { v[j] = v[j] - mean; s2 += (v[j].x * v[j].x + v[j].y * v[j].y) + (v[j].z * v[j].z + v[j].w * v[j].w); }
    const float rstd = 1.f / sqrtf(wave_sum(s2) * (1.f / DM) + LN_EPS);
#pragma unroll
    for (int j = 0; j < 4; ++j) {
        const f32x4 gg = ((const f32x4*)g)[lane + 64 * j], bb = ((const f32x4*)b)[lane + 64 * j];
        const f32x4 o = v[j] * rstd * gg + bb;
        ((f32x4*)dstf)[lane + 64 * j] = o;
        v2u w; w.x = pk2(o.x, o.y); w.y = pk2(o.z, o.w);
        ((v2u*)dstb)[lane + 64 * j] = w;
    }
}
__device__ __forceinline__ void ln_phase(const float* g, const float* b, float* io, bf16* xn, int gw, int ngw, int lane) {
    for (int m = gw; m < M; m += ngw) ln_row(io + (size_t)m * DM, g, b, io + (size_t)m * DM, xn + (size_t)m * DM, lane);
}

__device__ __forceinline__ void prologue(const Params& p, unsigned char* lds, int tid) {
    const int lane = tid & 63, wave = tid >> 6;
    const int gw = blockIdx.x * 8 + wave, ngw = gridDim.x * 8;
    float* scr = (float*)(lds + wave * 16384);
    constexpr int I_IN = (DM / 64) * (DIN / 32), I_OUT = (DM / 64) * (DM / 32), I_UP = (DM / 64) * (DFF / 32), I_DN = (DFF / 64) * (DM / 32);
    constexpr int I_L = I_IN + I_OUT + I_UP + I_DN;
    for (int it = gw; it < DEPTH * I_L; it += ngw) {
        const int l = it / I_L; int r = it % I_L;
        bf16* wb = (bf16*)(p.ws + WS_W + (size_t)l * W_LAYER_B);
        if (r < I_IN) { p0_transpose_item(p.in[3] + (size_t)l * DM * DIN, DM, DIN, wb, scr, r, lane); continue; } r -= I_IN;
        if (r < I_OUT) { p0_transpose_item(p.in[14] + (size_t)l * DM * DM, DM, DM, wb + (size_t)DIN * DM, scr, r, lane); continue; } r -= I_OUT;
        if (r < I_UP) { p0_transpose_item(p.in[17] + (size_t)l * DM * DFF, DM, DFF, wb + (size_t)DIN * DM + (size_t)DM * DM, scr, r, lane); continue; } r -= I_UP;
        p0_transpose_item(p.in[18] + (size_t)l * DFF * DM, DFF, DM, wb + (size_t)DIN * DM + (size_t)DM * DM + (size_t)DFF * DM, scr, r, lane);
    }
    for (int m = gw; m < M; m += ngw) ln_row(p.in[0] + (size_t)m * DM, p.in[1], p.in[2], p.out + (size_t)m * DM, (bf16*)(p.ws + WS_XN) + (size_t)m * DM, lane);
#if defined(MK_ZERO_DIAG)
    { v4u* z = (v4u*)(p.ws + WS_Y); const size_t n = (WS_LB - WS_Y) / 16; for (size_t i = (size_t)blockIdx.x * 512 + tid; i < n; i += (size_t)gridDim.x * 512) z[i] = (v4u){0u, 0u, 0u, 0u}; }
#endif
    {
        float* rc = (float*)(p.ws + WS_ROPE); float* rs = rc + SEQ * 32;
        for (int i = blockIdx.x * 512 + tid; i < SEQ * 32; i += gridDim.x * 512) {
            const int pos = i >> 5, f = i & 31;
            const float inv = powf(10000.f, -(float)(2 * f) / 64.f);
            const float ang = (float)pos * inv;
            const float n = rintf(ang * 0.15915494309189535f);
            float r = fmaf(-n, 6.2831854820251465f, ang); r = fmaf(-n, -1.7484555e-7f, r);
            rc[i] = __cosf(r); rs[i] = __sinf(r);
        }
    }
    if (blockIdx.x == 0 && tid < GW) {
        const float* lg = p.in[12]; float* lb = (float*)(p.ws + WS_LB);
        float mx = lg[tid]; for (int l = 1; l < DEPTH; ++l) mx = fmaxf(mx, lg[l * GW + tid]);
        float den = 0.f; for (int l = 0; l < DEPTH; ++l) den += expf(lg[l * GW + tid] - mx);
        const float p0 = expf(lg[tid] - mx) / den; float cum = 0.f;
        for (int l = 0; l < DEPTH; ++l) { cum += expf(lg[l * GW + tid] - mx) / den; lb[l * GW + tid] = cum - p0; }
    }
}

constexpr int L_KS = 0;
constexpr int L_VT = 18432;
constexpr int L_ST = 35840;
constexpr int L_BS = 45056;
constexpr int L_KF = 79872;
constexpr int L_TOT = 114688;
constexpr int L_FLAG = 120000;
constexpr int L_WAT = 18432, L_WXT = 27648, L_AS = 36864, L_US = 71680, L_SEGA = 106496, L_SEGH = 108544;

__device__ __forceinline__ void stage_vt(bf16* Vt, const bf16* Vg, int tid) {
    const int s = tid & 127, eg = tid >> 7;
    const bf16* src = Vg + (size_t)s * DIN + 16 * eg;
    const v4u a = *(const v4u*)src, c = *(const v4u*)(src + 8);
    bf16* vt = Vt + (16 * eg) * 136 + s;
    vt[0 * 136] = (bf16)(a.x & 0xffffu); vt[1 * 136] = (bf16)(a.x >> 16); vt[2 * 136] = (bf16)(a.y & 0xffffu); vt[3 * 136] = (bf16)(a.y >> 16);
    vt[4 * 136] = (bf16)(a.z & 0xffffu); vt[5 * 136] = (bf16)(a.z >> 16); vt[6 * 136] = (bf16)(a.w & 0xffffu); vt[7 * 136] = (bf16)(a.w >> 16);
    vt[8 * 136] = (bf16)(c.x & 0xffffu); vt[9 * 136] = (bf16)(c.x >> 16); vt[10 * 136] = (bf16)(c.y & 0xffffu); vt[11 * 136] = (bf16)(c.y >> 16);
    vt[12 * 136] = (bf16)(c.z & 0xffffu); vt[13 * 136] = (bf16)(c.z >> 16); vt[14 * 136] = (bf16)(c.w & 0xffffu); vt[15 * 136] = (bf16)(c.w >> 16);
}
__device__ __forceinline__ bf16x8 vt_frag2(const bf16* Vt, int e, int lo, int hi, int q4) {
    const v2u a = *(const v2u*)(Vt + e * 136 + 16 * lo + 4 * q4), c = *(const v2u*)(Vt + e * 136 + 16 * hi + 4 * q4);
    v4u w; w.x = a.x; w.y = a.y; w.z = c.x; w.w = c.y; return __builtin_bit_cast(bf16x8, w);
}
__device__ __forceinline__ void kv_product(const bf16* Kt, const bf16* Vt, float* out, int w, int c16, int q4) {
    const int dt = w >> 1, et0 = 2 * (w & 1);
    f32x4 acc[2] = {{0.f, 0.f, 0.f, 0.f}, {0.f, 0.f, 0.f, 0.f}};
#pragma unroll
    for (int ks = 0; ks < 4; ++ks) {
        const bf16x8 a = *(const bf16x8*)(Kt + (16 * dt + c16) * 136 + 32 * ks + 8 * q4);
#pragma unroll
        for (int e2 = 0; e2 < 2; ++e2) { const bf16x8 b = *(const bf16x8*)(Vt + (16 * (et0 + e2) + c16) * 136 + 32 * ks + 8 * q4); acc[e2] = MFMA16(a, b, acc[e2]); }
    }
#pragma unroll
    for (int e2 = 0; e2 < 2; ++e2)
#pragma unroll
        for (int r = 0; r < 4; ++r) out[(16 * dt + 4 * q4 + r) * 64 + 16 * (et0 + e2) + c16] = acc[e2][r];
}

__device__ __forceinline__ void c_tile(const bf16* Ks, const bf16x8 (&Qf)[2], int j, int sbase, int tq, int lane, int c16, int q4, float& R, float (&wv)[4]) {
    const bf16x8 k0 = *(const bf16x8*)(Ks + (16 * j + c16) * 72 + 8 * q4), k1 = *(const bf16x8*)(Ks + (16 * j + c16) * 72 + 32 + 8 * q4);
    f32x4 z = {0.f, 0.f, 0.f, 0.f};
    z = MFMA16(k0, Qf[0], z); z = MFMA16(k1, Qf[1], z);
    float lk[4], ls[4]; bool valid[4];
#pragma unroll
    for (int r = 0; r < 4; ++r) { const float zz = z[r] * 0.125f; valid[r] = (sbase + 16 * j + 4 * q4 + r) < tq; const float sp = softplusf_(zz); lk[r] = valid[r] ? -sp : 0.f; ls[r] = zz - sp; }
    const float suf2 = lk[3], suf1 = suf2 + lk[2], suf0 = suf1 + lk[1], T = suf0 + lk[0];
    const float t1 = __shfl(T, (lane + 16) & 63), t2 = __shfl(T, (lane + 32) & 63), t3 = __shfl(T, (lane + 48) & 63);
    const float X = (q4 < 3 ? t1 : 0.f) + (q4 < 2 ? t2 : 0.f) + (q4 < 1 ? t3 : 0.f);
    float tot = T + __shfl_xor(T, 16); tot += __shfl_xor(tot, 32);
    const float base = R + X;
    wv[0] = valid[0] ? __expf(ls[0] + base + suf0) : 0.f;
    wv[1] = valid[1] ? __expf(ls[1] + base + suf1) : 0.f;
    wv[2] = valid[2] ? __expf(ls[2] + base + suf2) : 0.f;
    wv[3] = valid[3] ? __expf(ls[3] + base) : 0.f;
    R += tot;
}
__device__ __forceinline__ void mixer_c_item(unsigned char* lds, const bf16* proj, bf16* Y, int item, int tid_in) {
    int tid = tid_in; asm volatile("" : "+v"(tid));
    const int lane = tid & 63, w = __builtin_amdgcn_readfirstlane(tid >> 6), c16 = lane & 15, q4 = lane >> 4;
    const int qb = 31 - (item & 31), bh = item >> 5, b = bh >> 2, h = bh & 3;
    const size_t row0 = (size_t)b * SEQ;
    const bf16* Qg = proj + 6 * GW + h * HD; const bf16* Kg = proj + 7 * GW + h * HD; const bf16* Vg = proj + 8 * GW + h * HD;
    bf16* Ks = (bf16*)(lds + L_KS); bf16* Vt = (bf16*)(lds + L_VT); volatile unsigned* flags = (volatile unsigned*)(lds + L_FLAG);
    const int tq = qb * 128 + 16 * w + c16;
    bf16x8 Qf[2];
    Qf[0] = *(const bf16x8*)(Qg + (row0 + tq) * DIN + 8 * q4); Qf[1] = *(const bf16x8*)(Qg + (row0 + tq) * DIN + 32 + 8 * q4);
    f32x4 accO[4];
#pragma unroll
    for (int et = 0; et < 4; ++et) accO[et] = (f32x4){0.f, 0.f, 0.f, 0.f};
    float R = 0.f; bool done = false;
    __syncthreads();
    for (int kb = qb; kb >= 0; --kb) {
        { const int s = tid >> 2, part = tid & 3; const bf16* src = Kg + (row0 + kb * 128 + s) * DIN + 16 * part;
          const v4u a = *(const v4u*)src, c = *(const v4u*)(src + 8); *(v4u*)(Ks + s * 72 + 16 * part) = a; *(v4u*)(Ks + s * 72 + 16 * part + 8) = c; }
        stage_vt(Vt, Vg + (row0 + kb * 128) * DIN, tid);
        __syncthreads();
        if (!done) {
            const int ptop = (kb == qb) ? (w >> 1) : 3;
            for (int pp = ptop; pp >= 0; --pp) {
                float wh[4], wl[4];
                c_tile(Ks, Qf, 2 * pp + 1, kb * 128, tq, lane, c16, q4, R, wh);
                c_tile(Ks, Qf, 2 * pp, kb * 128, tq, lane, c16, q4, R, wl);
                const float pv[8] = {wl[0], wl[1], wl[2], wl[3], wh[0], wh[1], wh[2], wh[3]};
                const bf16x8 P = pack8(pv);
#pragma unroll
                for (int et = 0; et < 4; ++et) accO[et] = MFMA16(vt_frag2(Vt, 16 * et + c16, 2 * pp, 2 * pp + 1, q4), P, accO[et]);
                if (__all(R < -104.f)) { done = true; break; }
            }
        }
        if (lane == 0) flags[w] = done ? 1u : 0u;
        __syncthreads();
        unsigned alld = 1u;
#pragma unroll
        for (int i = 0; i < 8; ++i) alld &= flags[i];
        if (alld) break;
    }
    bf16* yp = Y + (row0 + tq) * DM + 2 * GW + h * HD + 4 * q4;
#pragma unroll
    for (int et = 0; et < 4; ++et) { v2u o; o.x = pk2(accO[et][0], accO[et][1]); o.y = pk2(accO[et][2], accO[et][3]); *(v2u*)(yp + 16 * et) = o; }
}

__device__ __forceinline__ void rope8(const bf16* src, const float* rc, const float* rs, int pos, int part, float (&r1)[8], float (&r2)[8]) {
    float x1[8], x2[8];
    unpack8(*(const v4u*)(src + 8 * part), x1); unpack8(*(const v4u*)(src + 32 + 8 * part), x2);
    const f32x4 c0 = *(const f32x4*)(rc + pos * 32 + 8 * part), c1 = *(const f32x4*)(rc + pos * 32 + 8 * part + 4);
    const f32x4 s0 = *(const f32x4*)(rs + pos * 32 + 8 * part), s1 = *(const f32x4*)(rs + pos * 32 + 8 * part + 4);
    const float cc[8] = {c0.x, c0.y, c0.z, c0.w, c1.x, c1.y, c1.z, c1.w}, ss[8] = {s0.x, s0.y, s0.z, s0.w, s1.x, s1.y, s1.z, s1.w};
#pragma unroll
    for (int i = 0; i < 8; ++i) { r1[i] = x1[i] * cc[i] - x2[i] * ss[i]; r2[i] = x1[i] * ss[i] + x2[i] * cc[i]; }
}
__device__ __forceinline__ void mixer_b_pass1(unsigned char* lds, const Params& p, const bf16* proj, int item, int tid_in) {
    int tid = tid_in; asm volatile("" : "+v"(tid));
    const int lane = tid & 63, w = __builtin_amdgcn_readfirstlane(tid >> 6), c16 = lane & 15, q4 = lane >> 4;
    const int c = item & 31, bh = item >> 5, b = bh >> 2, h = bh & 3;
    const size_t row0 = (size_t)b * SEQ;
    const float* rc = (const float*)(p.ws + WS_ROPE); const float* rs = rc + SEQ * 32;
    bf16* Kt = (bf16*)(lds + L_KS); bf16* Vt = (bf16*)(lds + L_VT);
    const float lg2 = log2f(1.f - exp2f(-5.f - (float)h));
    __syncthreads();
    {
        const int s = tid & 127, part = tid >> 7, pos = c * 128 + s;
        float r1[8], r2[8];
        rope8(proj + (row0 + pos) * DIN + 3 * GW + h * HD, rc, rs, pos, part, r1, r2);
        const float sc = 0.125f * exp2f(lg2 * (float)(127 - s));
#pragma unroll
        for (int i = 0; i < 8; ++i) { Kt[(8 * part + i) * 136 + s] = f2bf(r1[i] * sc); Kt[(32 + 8 * part + i) * 136 + s] = f2bf(r2[i] * sc); }
    }
    stage_vt(Vt, proj + (row0 + c * 128) * DIN + 4 * GW + h * HD, tid);
    __syncthreads();
    kv_product(Kt, Vt, (float*)(p.ws + WS_KVB) + (size_t)item * 4096, w, c16, q4);
}
__device__ __forceinline__ void mixer_b_pass2(unsigned char* lds, const Params& p, const bf16* proj, bf16* Y, int l, int item, int tid_in) {
    int tid = tid_in; asm volatile("" : "+v"(tid));
    const int lane = tid & 63, w = __builtin_amdgcn_readfirstlane(tid >> 6), c16 = lane & 15, q4 = lane >> 4;
    const int c = item & 31, bh = item >> 5, b = bh >> 2, h = bh & 3;
    const size_t row0 = (size_t)b * SEQ;
    const float* rc = (const float*)(p.ws + WS_ROPE); const float* rs = rc + SEQ * 32;
    bf16* Ks = (bf16*)(lds + L_KS); bf16* Vt = (bf16*)(lds + L_VT); bf16* St = (bf16*)(lds + L_ST);
    const float lg2 = log2f(1.f - exp2f(-5.f - (float)h));
    __syncthreads();
    {
        const int e = tid & 63, dg = tid >> 6;
        float S[8];
#pragma unroll
        for (int i = 0; i < 8; ++i) S[i] = 0.f;
        const float* kv = (const float*)(p.ws + WS_KVB) + (size_t)(bh * 32) * 4096 + (8 * dg) * 64 + e;
#pragma unroll
        for (int i = 0; i < 8; ++i) S[i] = kv[(size_t)c * 4096 + i * 64];
        *(bf16x8*)(St + e * 72 + 8 * dg) = pack8(S);
    }
    {
        const int s = tid >> 2, part = tid & 3, pos = c * 128 + s;
        float r1[8], r2[8];
        rope8(proj + (row0 + pos) * DIN + 3 * GW + h * HD, rc, rs, pos, part, r1, r2);
#pragma unroll
        for (int i = 0; i < 8; ++i) { r1[i] *= 0.125f; r2[i] *= 0.125f; }
        *(bf16x8*)(Ks + s * 72 + 8 * part) = pack8(r1); *(bf16x8*)(Ks + s * 72 + 32 + 8 * part) = pack8(r2);
    }
    stage_vt(Vt, proj + (row0 + c * 128) * DIN + 4 * GW + h * HD, tid);
    __syncthreads();
    const int tl = 16 * w + c16, pos = c * 128 + tl;
    bf16x8 Qf[2];
    { float r1[8], r2[8]; rope8(proj + (row0 + pos) * DIN + 2 * GW + h * HD, rc, rs, pos, q4, r1, r2); Qf[0] = pack8(r1); Qf[1] = pack8(r2); }
    f32x4 accO[4];
    const float qd = exp2f(lg2 * (float)(tl + 1));
#pragma unroll
    for (int et = 0; et < 4; ++et) {
        f32x4 a = {0.f, 0.f, 0.f, 0.f};
        a = MFMA16(*(const bf16x8*)(St + (16 * et + c16) * 72 + 8 * q4), Qf[0], a);
        a = MFMA16(*(const bf16x8*)(St + (16 * et + c16) * 72 + 32 + 8 * q4), Qf[1], a);
        accO[et] = a * qd;
    }
    for (int pp = (w >> 1); pp >= 0; --pp) {
        float pv[8];
#pragma unroll
        for (int hh = 0; hh < 2; ++hh) {
            const int j = 2 * pp + hh;
            f32x4 z = {0.f, 0.f, 0.f, 0.f};
            z = MFMA16(*(const bf16x8*)(Ks + (16 * j + c16) * 72 + 8 * q4), Qf[0], z);
            z = MFMA16(*(const bf16x8*)(Ks + (16 * j + c16) * 72 + 32 + 8 * q4), Qf[1], z);
#pragma unroll
            for (int r = 0; r < 4; ++r) { const int df = tl - (16 * j + 4 * q4 + r); pv[4 * hh + r] = (df >= 0) ? z[r] * exp2f(lg2 * (float)df) : 0.f; }
        }
        const bf16x8 P = pack8(pv);
#pragma unroll
        for (int et = 0; et < 4; ++et) accO[et] = MFMA16(vt_frag2(Vt, 16 * et + c16, 2 * pp, 2 * pp + 1, q4), P, accO[et]);
    }
    float s = 0.f;
#pragma unroll
    for (int et = 0; et < 4; ++et) s += (accO[et][0] + accO[et][1]) + (accO[et][2] + accO[et][3]);
    s += __shfl_xor(s, 16); s += __shfl_xor(s, 32);
    const float mu = s * (1.f / 64.f); float qv = 0.f;
#pragma unroll
    for (int et = 0; et < 4; ++et)
#pragma unroll
        for (int r = 0; r < 4; ++r) { const float d = accO[et][r] - mu; qv += d * d; }
    qv += __shfl_xor(qv, 16); qv += __shfl_xor(qv, 32);
    const float rstd = 1.f / sqrtf(qv * (1.f / 64.f) + NORM_EPS);
    const float* ng = p.in[11] + l * GW + h * HD + 4 * q4;
    const bf16* gp = proj + (row0 + pos) * DIN + 5 * GW + h * HD + 4 * q4;
    bf16* yp = Y + (row0 + pos) * DM + 1 * GW + h * HD + 4 * q4;
#pragma unroll
    for (int et = 0; et < 4; ++et) {
        const f32x4 g4 = *(const f32x4*)(ng + 16 * et); const v2u gg = *(const v2u*)(gp + 16 * et);
        const float o0 = (accO[et][0] - mu) * rstd * g4.x * siluf_(bflo(gg.x)), o1 = (accO[et][1] - mu) * rstd * g4.y * siluf_(bfhi(gg.x));
        const float o2 = (accO[et][2] - mu) * rstd * g4.z * siluf_(bflo(gg.y)), o3 = (accO[et][3] - mu) * rstd * g4.w * siluf_(bfhi(gg.y));
        v2u o; o.x = pk2(o0, o1); o.y = pk2(o2, o3); *(v2u*)(yp + 16 * et) = o;
    }
}

__device__ __forceinline__ void d_gates(unsigned char* lds, const Params& p, const bf16* proj, int l, int bh, int c, int tid, float (&bl)[16], float (&kk)[16], float& bend) {
    const int ch = tid & 63, blk = tid >> 6, b = bh >> 2, h = bh & 3;
    const size_t row0 = (size_t)b * SEQ;
    float* tot = (float*)(lds + L_TOT);
    const float lb = ((const float*)(p.ws + WS_LB))[l * GW + h * HD + ch];
    const bf16* fp = proj + (row0 + c * 128 + 16 * blk) * DIN + 10 * GW + h * HD + ch;
    float run = 0.f;
#pragma unroll
    for (int i = 0; i < 16; ++i) {
        float x = bf1(fp[(size_t)i * DIN]); x = fminf(fmaxf(x, -80.f), 80.f);
        const float ex = __expf(-x), sg = __builtin_amdgcn_rcpf(1.f + ex);
        const float f = lb + (1.f - lb) * sg;
        run += __logf(fmaxf(f, 1e-30f));
        bl[i] = run; kk[i] = (1.f - lb) * (ex * sg);
    }
    tot[blk * 64 + ch] = run;
    __syncthreads();
    float pre = 0.f, all = 0.f;
#pragma unroll
    for (int s = 0; s < 8; ++s) { const float t = tot[s * 64 + ch]; all += t; pre += (s < blk) ? t : 0.f; }
#pragma unroll
    for (int i = 0; i < 16; ++i) bl[i] += pre;
    bend = all;
}
__device__ __forceinline__ void mixer_d_pass1(unsigned char* lds, const Params& p, const bf16* proj, int l, int item, int tid_in) {
    int tid = tid_in; asm volatile("" : "+v"(tid));
    const int lane = tid & 63, w = __builtin_amdgcn_readfirstlane(tid >> 6), c16 = lane & 15, q4 = lane >> 4;
    const int c = item & 31, bh = item >> 5, b = bh >> 2, h = bh & 3;
    const size_t row0 = (size_t)b * SEQ;
    bf16* Kt = (bf16*)(lds + L_KS); bf16* Vt = (bf16*)(lds + L_VT);
    __syncthreads();
    float bl[16], kk[16], bend;
    d_gates(lds, p, proj, l, bh, c, tid, bl, kk, bend);
    {
        const int ch = tid & 63, blk = tid >> 6;
        float k0[8], k1[8];
#pragma unroll
        for (int i = 0; i < 8; ++i) { k0[i] = kk[i] * __expf(bend - bl[i]); k1[i] = kk[8 + i] * __expf(bend - bl[8 + i]); }
        *(bf16x8*)(Kt + ch * 136 + 16 * blk) = pack8(k0); *(bf16x8*)(Kt + ch * 136 + 16 * blk + 8) = pack8(k1);
        if (blk == 0) ((float*)(p.ws + WS_DVEC))[(size_t)item * 64 + ch] = __expf(bend);
    }
    stage_vt(Vt, proj + (row0 + c * 128) * DIN + 11 * GW + h * HD, tid);
    __syncthreads();
    kv_product(Kt, Vt, (float*)(p.ws + WS_KVD) + (size_t)item * 4096, w, c16, q4);
}
__device__ __forceinline__ void mixer_d_pass2(unsigned char* lds, const Params& p, const bf16* proj, bf16* Y, int l, int item, int tid_in) {
    int tid = tid_in; asm volatile("" : "+v"(tid));
    const int lane = tid & 63, w = __builtin_amdgcn_readfirstlane(tid >> 6), c16 = lane & 15, q4 = lane >> 4;
    const int c = item & 31, bh = item >> 5, b = bh >> 2, h = bh & 3;
    const size_t row0 = (size_t)b * SEQ;
    bf16* Vt = (bf16*)(lds + L_VT); bf16* St = (bf16*)(lds + L_ST); float* bS = (float*)(lds + L_BS); float* kS = (float*)(lds + L_KF);
    __syncthreads();
    {
        float bl[16], kk[16], bend;
        d_gates(lds, p, proj, l, bh, c, tid, bl, kk, bend);
        const int ch = tid & 63, blk = tid >> 6;
#pragma unroll
        for (int i = 0; i < 16; ++i) { bS[(16 * blk + i) * 68 + ch] = bl[i]; kS[(16 * blk + i) * 68 + ch] = kk[i]; }
    }
    {
        const int e = tid & 63, dg = tid >> 6;
        float S[8];
#pragma unroll
        for (int i = 0; i < 8; ++i) S[i] = 0.f;
        const float* kv = (const float*)(p.ws + WS_KVD) + (size_t)(bh * 32) * 4096 + (8 * dg) * 64 + e;
#pragma unroll
        for (int i = 0; i < 8; ++i) S[i] = kv[(size_t)c * 4096 + i * 64];
        *(bf16x8*)(St + e * 72 + 8 * dg) = pack8(S);
    }
    stage_vt(Vt, proj + (row0 + c * 128) * DIN + 11 * GW + h * HD, tid);
    __syncthreads();
    const int tl = 16 * w + c16, pos = c * 128 + tl;
    float qv[16], bt[16], Bp[16];
    { const bf16* qp = proj + (row0 + pos) * DIN + 9 * GW + h * HD + 8 * q4; float a[8], bb[8]; unpack8(*(const v4u*)qp, a); unpack8(*(const v4u*)(qp + 32), bb);
#pragma unroll
      for (int i = 0; i < 8; ++i) { qv[i] = a[i]; qv[8 + i] = bb[i]; } }
#pragma unroll
    for (int ks = 0; ks < 2; ++ks) {
        const f32x4 b0 = *(const f32x4*)(bS + tl * 68 + 32 * ks + 8 * q4), b1 = *(const f32x4*)(bS + tl * 68 + 32 * ks + 8 * q4 + 4);
        bt[8 * ks + 0] = b0.x; bt[8 * ks + 1] = b0.y; bt[8 * ks + 2] = b0.z; bt[8 * ks + 3] = b0.w; bt[8 * ks + 4] = b1.x; bt[8 * ks + 5] = b1.y; bt[8 * ks + 6] = b1.z; bt[8 * ks + 7] = b1.w;
        if (w > 0) {
            const f32x4 p0 = *(const f32x4*)(bS + (16 * w - 1) * 68 + 32 * ks + 8 * q4), p1 = *(const f32x4*)(bS + (16 * w - 1) * 68 + 32 * ks + 8 * q4 + 4);
            Bp[8 * ks + 0] = p0.x; Bp[8 * ks + 1] = p0.y; Bp[8 * ks + 2] = p0.z; Bp[8 * ks + 3] = p0.w; Bp[8 * ks + 4] = p1.x; Bp[8 * ks + 5] = p1.y; Bp[8 * ks + 6] = p1.z; Bp[8 * ks + 7] = p1.w;
        } else {
#pragma unroll
            for (int i = 0; i < 8; ++i) Bp[8 * ks + i] = 0.f;
        }
    }
    bf16x8 Qh[2], Qt[2];
#pragma unroll
    for (int ks = 0; ks < 2; ++ks) {
        float a[8], t[8];
#pragma unroll
        for (int i = 0; i < 8; ++i) { a[i] = qv[8 * ks + i] * __expf(bt[8 * ks + i]); t[i] = qv[8 * ks + i] * __expf(bt[8 * ks + i] - Bp[8 * ks + i]); }
        Qh[ks] = pack8(a); Qt[ks] = pack8(t);
    }
    f32x4 accO[4];
#pragma unroll
    for (int et = 0; et < 4; ++et) {
        f32x4 a = {0.f, 0.f, 0.f, 0.f};
        a = MFMA16(*(const bf16x8*)(St + (16 * et + c16) * 72 + 8 * q4), Qh[0], a);
        a = MFMA16(*(const bf16x8*)(St + (16 * et + c16) * 72 + 32 + 8 * q4), Qh[1], a);
        accO[et] = a;
    }
    for (int pp = 0; 2 * pp < w; ++pp) {
        float pv[8];
#pragma unroll
        for (int hh = 0; hh < 2; ++hh) {
            const int j = 2 * pp + hh;
            if (j < w) {
                f32x4 z = {0.f, 0.f, 0.f, 0.f};
#pragma unroll
                for (int ks = 0; ks < 2; ++ks) {
                    const float* kr = kS + (16 * j + c16) * 68 + 32 * ks + 8 * q4; const float* br = bS + (16 * j + c16) * 68 + 32 * ks + 8 * q4;
                    const f32x4 k0 = *(const f32x4*)kr, k1 = *(const f32x4*)(kr + 4), b0 = *(const f32x4*)br, b1 = *(const f32x4*)(br + 4);
                    float kt[8];
                    kt[0] = k0.x * __expf(Bp[8 * ks + 0] - b0.x); kt[1] = k0.y * __expf(Bp[8 * ks + 1] - b0.y); kt[2] = k0.z * __expf(Bp[8 * ks + 2] - b0.z); kt[3] = k0.w * __expf(Bp[8 * ks + 3] - b0.w);
                    kt[4] = k1.x * __expf(Bp[8 * ks + 4] - b1.x); kt[5] = k1.y * __expf(Bp[8 * ks + 5] - b1.y); kt[6] = k1.z * __expf(Bp[8 * ks + 6] - b1.z); kt[7] = k1.w * __expf(Bp[8 * ks + 7] - b1.w);
                    z = MFMA16(pack8(kt), Qt[ks], z);
                }
#pragma unroll
                for (int r = 0; r < 4; ++r) pv[4 * hh + r] = z[r];
            } else {
#pragma unroll
                for (int r = 0; r < 4; ++r) pv[4 * hh + r] = 0.f;
            }
        }
        const bf16x8 P = pack8(pv);
#pragma unroll
        for (int et = 0; et < 4; ++et) accO[et] = MFMA16(vt_frag2(Vt, 16 * et + c16, 2 * pp, 2 * pp + 1, q4), P, accO[et]);
    }
    {
        float pd[8];
#pragma unroll
        for (int i = 0; i < 8; ++i) pd[i] = 0.f;
#pragma unroll
        for (int si = 0; si < 16; ++si) {
            const float* kr = kS + (16 * w + si) * 68 + 8 * q4; const float* br = bS + (16 * w + si) * 68 + 8 * q4;
            float v = 0.f;
#pragma unroll
            for (int ks = 0; ks < 2; ++ks) {
                const f32x4 k0 = *(const f32x4*)(kr + 32 * ks), k1 = *(const f32x4*)(kr + 32 * ks + 4), b0 = *(const f32x4*)(br + 32 * ks), b1 = *(const f32x4*)(br + 32 * ks + 4);
                v += qv[8 * ks + 0] * k0.x * __expf(fminf(bt[8 * ks + 0] - b0.x, 0.f)); v += qv[8 * ks + 1] * k0.y * __expf(fminf(bt[8 * ks + 1] - b0.y, 0.f));
                v += qv[8 * ks + 2] * k0.z * __expf(fminf(bt[8 * ks + 2] - b0.z, 0.f)); v += qv[8 * ks + 3] * k0.w * __expf(fminf(bt[8 * ks + 3] - b0.w, 0.f));
                v += qv[8 * ks + 4] * k1.x * __expf(fminf(bt[8 * ks + 4] - b1.x, 0.f)); v += qv[8 * ks + 5] * k1.y * __expf(fminf(bt[8 * ks + 5] - b1.y, 0.f));
                v += qv[8 * ks + 6] * k1.z * __expf(fminf(bt[8 * ks + 6] - b1.z, 0.f)); v += qv[8 * ks + 7] * k1.w * __expf(fminf(bt[8 * ks + 7] - b1.w, 0.f));
            }
            v += __shfl_xor(v, 16); v += __shfl_xor(v, 32);
            const float wv = (si <= c16) ? v : 0.f;
            if (q4 == (si >> 3)) pd[si & 7] = wv;
        }
        const bf16x8 P = pack8(pd);
        const bf16x8 zero8 = {0, 0, 0, 0, 0, 0, 0, 0};
#pragma unroll
        for (int et = 0; et < 4; ++et) {
            bf16x8 vf = zero8;
            if (q4 < 2) vf = *(const bf16x8*)(Vt + (16 * et + c16) * 136 + 16 * w + 8 * q4);
            accO[et] = MFMA16(vf, P, accO[et]);
        }
    }
    float ss = 0.f;
#pragma unroll
    for (int et = 0; et < 4; ++et)
#pragma unroll
        for (int r = 0; r < 4; ++r) ss += accO[et][r] * accO[et][r];
    ss += __shfl_xor(ss, 16); ss += __shfl_xor(ss, 32);
    const float rstd = 1.f / sqrtf(ss * (1.f / 64.f) + NORM_EPS);
    const float* ng = p.in[13] + l * GW + h * HD + 4 * q4;
    const bf16* gp = proj + (row0 + pos) * DIN + 12 * GW + h * HD + 4 * q4;
    bf16* yp = Y + (row0 + pos) * DM + 3 * GW + h * HD + 4 * q4;
#pragma unroll
    for (int et = 0; et < 4; ++et) {
        const f32x4 g4 = *(const f32x4*)(ng + 16 * et); const v2u gg = *(const v2u*)(gp + 16 * et);
        const float o0 = accO[et][0] * rstd * g4.x * siluf_(bflo(gg.x)), o1 = accO[et][1] * rstd * g4.y * siluf_(bfhi(gg.x));
        const float o2 = accO[et][2] * rstd * g4.z * siluf_(bflo(gg.y)), o3 = accO[et][3] * rstd * g4.w * siluf_(bfhi(gg.y));
        v2u o; o.x = pk2(o0, o1); o.y = pk2(o2, o3); *(v2u*)(yp + 16 * et) = o;
    }
}

template <int PASS>
__device__ __forceinline__ void mixer_a(unsigned char* lds, const Params& p, const bf16* proj, bf16* Y, int l, int item, int tid_in) {
    int tid = tid_in; asm volatile("" : "+v"(tid));
    const int lane = tid & 63, w = __builtin_amdgcn_readfirstlane(tid >> 6), c16 = lane & 15, q4 = lane >> 4;
    const int c = item & 31, bh = item >> 5, b = bh >> 2, h = bh & 3;
    const size_t row0 = (size_t)b * SEQ;
    bf16* Xs = (bf16*)(lds + L_KS); bf16* Wat = (bf16*)(lds + L_WAT); bf16* Wxt = (bf16*)(lds + L_WXT);
    float* aS = (float*)(lds + L_AS); float* uS = (float*)(lds + L_US); float* segA = (float*)(lds + L_SEGA); float* segH = (float*)(lds + L_SEGH);
    const int ch = tid & 63, blk = tid >> 6, col = h * HD + ch;
    __syncthreads();
    {
        const float* cwp = p.in[4] + (size_t)l * 4 * GW + col;
        const float cw0 = cwp[0], cw1 = cwp[GW], cw2 = cwp[2 * GW], cw3 = cwp[3 * GW], cb = p.in[5][l * GW + col];
        const int t0 = c * 128 + 16 * blk;
        const bf16* xp = proj + (row0 + t0) * DIN + col;
        float xm3 = (t0 >= 3) ? bf1(*(xp - 3 * (ptrdiff_t)DIN)) : 0.f, xm2 = (t0 >= 2) ? bf1(*(xp - 2 * (ptrdiff_t)DIN)) : 0.f, xm1 = (t0 >= 1) ? bf1(*(xp - (ptrdiff_t)DIN)) : 0.f;
#pragma unroll
        for (int i = 0; i < 16; ++i) {
            const float x = bf1(xp[(size_t)i * DIN]);
            const float xc = cb + cw0 * xm3 + cw1 * xm2 + cw2 * xm1 + cw3 * x;
            Xs[(16 * blk + i) * 72 + ch] = f2bf(xc);
            xm3 = xm2; xm2 = xm1; xm1 = x;
        }
        const float* wa = p.in[6] + (size_t)(l * NH + h) * 4096; const float* wx = p.in[8] + (size_t)(l * NH + h) * 4096;
#pragma unroll
        for (int k = 0; k < 8; ++k) { const int idx = tid + 512 * k, i = idx >> 6, j = idx & 63; Wat[j * 72 + i] = f2bf(wa[idx]); Wxt[j * 72 + i] = f2bf(wx[idx]); }
    }
    __syncthreads();
    {
        const bf16x8 x0 = *(const bf16x8*)(Xs + (16 * w + c16) * 72 + 8 * q4), x1 = *(const bf16x8*)(Xs + (16 * w + c16) * 72 + 32 + 8 * q4);
#pragma unroll
        for (int jt = 0; jt < 4; ++jt) {
            f32x4 ga = {0.f, 0.f, 0.f, 0.f}, gx = {0.f, 0.f, 0.f, 0.f};
            ga = MFMA16(x0, *(const bf16x8*)(Wat + (16 * jt + c16) * 72 + 8 * q4), ga); ga = MFMA16(x1, *(const bf16x8*)(Wat + (16 * jt + c16) * 72 + 32 + 8 * q4), ga);
            gx = MFMA16(x0, *(const bf16x8*)(Wxt + (16 * jt + c16) * 72 + 8 * q4), gx); gx = MFMA16(x1, *(const bf16x8*)(Wxt + (16 * jt + c16) * 72 + 32 + 8 * q4), gx);
            const int j = 16 * jt + c16, cj = l * GW + h * HD + j;
            const float ba = p.in[7][cj], bx = p.in[9][cj];
            const float lam = p.in[10][cj];
            const float lsl = -(fmaxf(-lam, 0.f) + log1pf(__expf(-fabsf(lam))));
#pragma unroll
            for (int r = 0; r < 4; ++r) {
                const int t = 16 * w + 4 * q4 + r;
                const float rr = sigmoidf_(ga[r] + ba), ii = sigmoidf_(gx[r] + bx);
                const float la = 8.f * rr * lsl;
                const float a = __expf(la), mult = sqrtf(fmaxf(-expm1f(2.f * la), 0.f));
                aS[t * 68 + j] = a; uS[t * 68 + j] = mult * ii * bf1(Xs[t * 72 + j]);
            }
        }
    }
    __syncthreads();
    {
        float As = 1.f, Hs = 0.f;
#pragma unroll
        for (int i = 0; i < 16; ++i) { const float a = aS[(16 * blk + i) * 68 + ch], u = uS[(16 * blk + i) * 68 + ch]; Hs = a * Hs + u; As *= a; }
        segA[blk * 64 + ch] = As; segH[blk * 64 + ch] = Hs;
    }
    __syncthreads();
    float* asum = (float*)(p.ws + WS_ASUM);
    if (PASS == 1) {
        if (blk == 7) {
            float A = 1.f, H = 0.f;
#pragma unroll
            for (int s = 0; s < 8; ++s) { const float sa = segA[s * 64 + ch]; H = sa * H + segH[s * 64 + ch]; A *= sa; }
            asum[((size_t)item * 64 + ch) * 2] = A; asum[((size_t)item * 64 + ch) * 2 + 1] = H;
        }
    } else {
        float hc = 0.f;
        hc = asum[((size_t)item * 64 + ch) * 2 + 1];
        for (int s = 0; s < blk; ++s) hc = segA[s * 64 + ch] * hc + segH[s * 64 + ch];
        const int t0 = c * 128 + 16 * blk;
        const bf16* gp = proj + (row0 + t0) * DIN + GW + col;
        bf16* yp = Y + (row0 + t0) * DM + col;
#pragma unroll
        for (int i = 0; i < 16; ++i) {
            hc = aS[(16 * blk + i) * 68 + ch] * hc + uS[(16 * blk + i) * 68 + ch];
            yp[(size_t)i * DM] = f2bf(gelu_tanh_(bf1(gp[(size_t)i * DIN])) * hc);
        }
    }
}

typedef __attribute__((address_space(1))) unsigned gu32;
#define XB_TMO      128
#define XB_XCNT(j)  (256  + 64 * (j))
#define XB_XSUB(j)  (1280 + 64 * (j))
#define XB_XGEN(j)  (2304 + 64 * (j))
#define XB_TOP      3328
#define XB_TOPGEN   3392
#define XCD_BAR_WORDS 3456
#define XB_SPIN_CAP (1u << 18)

__device__ __forceinline__ unsigned xb_ld(unsigned* p)              { return __hip_atomic_load(p, __ATOMIC_RELAXED, __HIP_MEMORY_SCOPE_AGENT); }
__device__ __forceinline__ unsigned xb_add(unsigned* p, unsigned v) { return __hip_atomic_fetch_add(p, v, __ATOMIC_RELAXED, __HIP_MEMORY_SCOPE_AGENT); }
__device__ __forceinline__ unsigned xb_xcc_id() { return (unsigned)__builtin_amdgcn_s_getreg((3 << 11) | 20) & 0xFu; }
#define XB_SPIN(cond, bar) do { unsigned _sp = 0; while (cond) { __builtin_amdgcn_s_sleep(1); \
    if ((++_sp & 255u) == 0u) { if (xb_ld(&(bar)[XB_TMO])) break; if (_sp > XB_SPIN_CAP) { atomicAdd(&(bar)[XB_TMO], 1u); break; } } } } while (0)

struct XcdBarrier {
    unsigned* bar; unsigned x;
    volatile LAS unsigned* st;
};

__device__ __forceinline__ XcdBarrier xcd_barrier_post(unsigned* bar, volatile LAS unsigned* st) {
    XcdBarrier b; b.bar = bar; b.x = xb_xcc_id(); b.st = st;
    if (threadIdx.x == 0) (void)xb_add(&bar[XB_XCNT(b.x)], 1u);
    return b;
}
__device__ __forceinline__ void xcd_barrier_complete(unsigned* bar, unsigned x, unsigned& nloc, unsigned& nx) {
    const unsigned G = gridDim.x * gridDim.y * gridDim.z;
    unsigned sum, cnt, mine, sp = 0u;
    for (;;) {
        sum = 0u; cnt = 0u; mine = 0u;
#pragma unroll
        for (unsigned j = 0; j < 16; ++j) { const unsigned c = xb_ld(&bar[XB_XCNT(j)]); sum += c; cnt += (c > 0u) ? 1u : 0u; mine = (j == x) ? c : mine; }
        if (sum == G) break;
        __builtin_amdgcn_s_sleep(1);
        if ((++sp & 255u) == 0u) { if (xb_ld(&bar[XB_TMO])) break; if (sp > XB_SPIN_CAP) { atomicAdd(&bar[XB_TMO], 1u); break; } }
    }
    nloc = mine > 0u ? mine : 1u; nx = cnt > 0u ? cnt : 1u;
}

__device__ __forceinline__ void xcd_barrier(const XcdBarrier& b) {
    asm volatile("s_waitcnt vmcnt(0)" ::: "memory");
    __syncthreads();
    if (threadIdx.x == 0) {
        unsigned* bar = b.bar;
        __builtin_amdgcn_s_waitcnt(0);
        unsigned nloc = b.st[0], nx = b.st[1];
        if (nloc == 0u) { xcd_barrier_complete(bar, b.x, nloc, nx); b.st[0] = nloc; b.st[1] = nx; }
        const unsigned old = xb_add(&bar[XB_XSUB(b.x)], 1u);
        const unsigned gen = old / nloc;
        if (old + 1u == (gen + 1u) * nloc) {
            __builtin_amdgcn_fence(__ATOMIC_RELEASE, "agent");
            asm volatile("s_waitcnt vmcnt(0)" ::: "memory");
            const unsigned og = xb_add(&bar[XB_TOP], 1u);
            const unsigned tg = og / nx;
            if (og + 1u == (tg + 1u) * nx) xb_add(&bar[XB_TOPGEN], 1u);
            else XB_SPIN(xb_ld(&bar[XB_TOPGEN]) == tg, bar);
            __builtin_amdgcn_fence(__ATOMIC_ACQUIRE, "agent");
            xb_add(&bar[XB_XGEN(b.x)], 1u);
            asm volatile("s_waitcnt vmcnt(0)" ::: "memory");
        } else {
            XB_SPIN(xb_ld(&bar[XB_XGEN(b.x)]) == gen, bar);
            __builtin_amdgcn_fence(__ATOMIC_ACQUIRE, "agent");
            asm volatile("s_waitcnt vmcnt(0)" ::: "memory");
        }
    }
    __syncthreads();
}


__device__ __forceinline__ void scan_phase(const Params& p, int tid) {
    const int nthr = gridDim.x * 512;
    for (int gt = blockIdx.x * 512 + tid; gt < 2 * 65536 + 1024; gt += nthr) {
        if (gt < 65536) {
            const int bh = gt >> 12, de = gt & 4095, h = bh & 3;
            const float Gam = exp2f(log2f(1.f - exp2f(-5.f - (float)h)) * 128.f);
            float* kv = (float*)(p.ws + WS_KVB) + (size_t)(bh * 32) * 4096 + de;
            float v[32];
#pragma unroll
            for (int c = 0; c < 32; ++c) v[c] = kv[(size_t)c * 4096];
            float S = 0.f;
#pragma unroll
            for (int c = 0; c < 32; ++c) { kv[(size_t)c * 4096] = S; S = Gam * S + v[c]; }
        } else if (gt < 2 * 65536) {
            const int g2 = gt - 65536, bh = g2 >> 12, de = g2 & 4095, d = de >> 6;
            float* kv = (float*)(p.ws + WS_KVD) + (size_t)(bh * 32) * 4096 + de;
            const float* dv = (const float*)(p.ws + WS_DVEC) + (size_t)(bh * 32) * 64 + d;
            float v[32], dd[32];
#pragma unroll
            for (int c = 0; c < 32; ++c) { v[c] = kv[(size_t)c * 4096]; dd[c] = dv[c * 64]; }
            float S = 0.f;
#pragma unroll
            for (int c = 0; c < 32; ++c) { kv[(size_t)c * 4096] = S; S = dd[c] * S + v[c]; }
        } else {
            const int g2 = gt - 2 * 65536, bh = g2 >> 6, ch = g2 & 63;
            float* as = (float*)(p.ws + WS_ASUM) + ((size_t)(bh * 32) * 64 + ch) * 2;
            float2 al[32];
#pragma unroll
            for (int c = 0; c < 32; ++c) al[c] = *(const float2*)(as + (size_t)c * 128);
            float H = 0.f;
#pragma unroll
            for (int c = 0; c < 32; ++c) { as[(size_t)c * 128 + 1] = H; H = al[c].x * H + al[c].y; }
        }
    }
}

__global__ void __launch_bounds__(512, 2) fwd_megakernel(Params p) {
    extern __shared__ __attribute__((aligned(16))) unsigned char lds[];
    cg::grid_group grid = cg::this_grid();
    const int G = gridDim.x;
    if (p.ws == nullptr) grid.sync();
    for (int u = threadIdx.x; u < 64; u += 512) ((volatile LAS unsigned*)((LAS unsigned char*)lds + 131072))[u] = 0u;
    __syncthreads();
    (void)xcd_barrier_post((unsigned*)(p.ws + WS_CTL) + CW_BAR, (volatile LAS unsigned*)((LAS unsigned char*)lds + 131072 + 32));
#define GRID_SYNC() do { XcdBarrier xb_; xb_.bar = (unsigned*)(p.ws + WS_CTL) + CW_BAR; xb_.x = xb_xcc_id(); xb_.st = (volatile LAS unsigned*)((LAS unsigned char*)lds + 131072 + 32); xcd_barrier(xb_); } while (0)
#define FRESH_TID() int tid = threadIdx.x; asm volatile("" : "+v"(tid)); const int lane = tid & 63, wave = tid >> 6, gw = blockIdx.x * 8 + wave, ngw = G * 8; (void)lane; (void)gw; (void)ngw;
    bf16* XN = (bf16*)(p.ws + WS_XN); bf16* PROJ = (bf16*)(p.ws + WS_PROJ); bf16* Y = (bf16*)(p.ws + WS_Y); bf16* U = (bf16*)(p.ws + WS_U);
    PG8_LAS unsigned char* glds = (PG8_LAS unsigned char*)lds;

    { FRESH_TID(); prologue(p, lds, tid); }
    GRID_SYNC();

    for (int l = 0; l < DEPTH; ++l) {
        const bf16* Wl = (const bf16*)(p.ws + WS_W + (size_t)l * W_LAYER_B);
        const bf16* Win_t = Wl; const bf16* Wout_t = Wl + (size_t)DIN * DM; const bf16* Wup_t = Wout_t + (size_t)DM * DM; const bf16* Wdn_t = Wup_t + (size_t)DFF * DM;
        {
            pg8::Gemm g{XN, Win_t, M, DIN, DM}; pg8::StaticOrder S; S.init(M, DIN, G, (int)blockIdx.x);
            pg8::EpiBf16<0> E{PROJ, DIN, nullptr, 0, 0, 1.f};
            pg8::gemm_phase<pg8::EpiBf16<0>, pg8::StaticOrder, true, true>(glds, g, S, E);
#ifdef MK_DUP_GEMM
            GRID_SYNC();
            pg8::gemm_phase<pg8::EpiBf16<0>, pg8::StaticOrder, true, true>(glds, g, S, E);
#endif
        }
        GRID_SYNC();
#if !defined(MK_SKELETON)
#ifdef MK_DUP_MIX
        for (int rep = 0; rep < 2; ++rep) {
#endif
        { FRESH_TID();
        for (int it = blockIdx.x; it < 3 * NITEM; it += G) {
            const int kind = it / NITEM, item = it % NITEM;
#ifndef MK_SKIP_D
            if (kind == 0) mixer_d_pass1(lds, p, PROJ, l, item, tid);
#endif
#ifndef MK_SKIP_B
            if (kind == 1) mixer_b_pass1(lds, p, PROJ, item, tid);
#endif
#ifndef MK_SKIP_A
            if (kind == 2) mixer_a<1>(lds, p, PROJ, Y, l, item, tid);
#endif
        } }
        GRID_SYNC();
        { FRESH_TID(); scan_phase(p, tid); }
        GRID_SYNC();
        { FRESH_TID();
        for (int it = blockIdx.x; it < 4 * NITEM; it += G) {
            const int kind = it / NITEM, item = it % NITEM;
#ifndef MK_SKIP_C
            if (kind == 0) mixer_c_item(lds, PROJ, Y, item, tid);
#endif
#ifndef MK_SKIP_D
            if (kind == 1) mixer_d_pass2(lds, p, PROJ, Y, l, item, tid);
#endif
#ifndef MK_SKIP_B
            if (kind == 2) mixer_b_pass2(lds, p, PROJ, Y, l, item, tid);
#endif
#ifndef MK_SKIP_A
            if (kind == 3) mixer_a<2>(lds, p, PROJ, Y, l, item, tid);
#endif
        } }
        __syncthreads();
#ifdef MK_DUP_MIX
        if (rep == 0) GRID_SYNC();
        }
#endif
#else
        { FRESH_TID(); for (int m = gw; m < M; m += ngw) { const v4u* s = (const v4u*)(PROJ + (size_t)m * DIN); v4u* d = (v4u*)(Y + (size_t)m * DM); d[lane] = s[lane]; d[lane + 64] = s[lane + 64]; } }
#endif
        GRID_SYNC();
        {
            pg8::Gemm g{Y, Wout_t, M, DM, DM}; pg8::StaticOrder S; S.init(M, DM, G, (int)blockIdx.x);
            pg8::EpiRes E{p.out, DM, ALPHA};
            pg8::gemm_phase<pg8::EpiRes, pg8::StaticOrder, true, true>(glds, g, S, E);
        }
        GRID_SYNC();
        { FRESH_TID(); ln_phase(p.in[15] + l * DM, p.in[16] + l * DM, p.out, XN, gw, ngw, lane); }
        GRID_SYNC();
        {
            pg8::Gemm g{XN, Wup_t, M, DFF, DM}; pg8::StaticOrder S; S.init(M, DFF, G, (int)blockIdx.x);
            pg8::EpiBf16<2> E{U, DFF, nullptr, 0, 0, 1.f};
            pg8::gemm_phase<pg8::EpiBf16<2>, pg8::StaticOrder, true, true>(glds, g, S, E);
#ifdef MK_DUP_GEMM
            GRID_SYNC();
            pg8::gemm_phase<pg8::EpiBf16<2>, pg8::StaticOrder, true, true>(glds, g, S, E);
#endif
        }
        GRID_SYNC();
        {
            pg8::Gemm g{U, Wdn_t, M, DM, DFF}; pg8::StaticOrder S; S.init(M, DM, G, (int)blockIdx.x);
            pg8::EpiRes E{p.out, DM, ALPHA};
            pg8::gemm_phase<pg8::EpiRes, pg8::StaticOrder, true, true>(glds, g, S, E);
        }
        GRID_SYNC();
        { FRESH_TID(); ln_phase(p.in[19] + l * DM, p.in[20] + l * DM, p.out, XN, gw, ngw, lane); }
        if (l + 1 < DEPTH) GRID_SYNC();
    }
}

extern "C" void kernel_launch(void* const* d_in, const int* in_sizes, int n_in, void* d_out, int out_size, void* d_ws, size_t ws_size, hipStream_t stream) {
    static int grid_blocks = 0;
    if (grid_blocks == 0) {
        if (n_in != 21 || out_size != M * DM || ws_size < WS_END) { fprintf(stderr, "kernel_launch: unexpected shapes (n_in %d out %d ws %zu)\n", n_in, out_size, ws_size); grid_blocks = -1; return; }
        int dev = 0, cus = 0, per_cu = 0;
        hipGetDevice(&dev);
        hipDeviceGetAttribute(&cus, hipDeviceAttributeMultiprocessorCount, dev);
        if (hipFuncSetAttribute((const void*)fwd_megakernel, hipFuncAttributeMaxDynamicSharedMemorySize, LDS_BYTES) != hipSuccess) { fprintf(stderr, "kernel_launch: hipFuncSetAttribute failed\n"); grid_blocks = -1; return; }
        if (hipOccupancyMaxActiveBlocksPerMultiprocessor(&per_cu, (const void*)fwd_megakernel, 512, LDS_BYTES) != hipSuccess || per_cu < 1) { fprintf(stderr, "kernel_launch: occupancy query gave %d\n", per_cu); per_cu = 1; }
        (void)hipGetLastError();
        grid_blocks = cus * 1;
        if (per_cu < 1) grid_blocks = cus;
    }
    if (grid_blocks < 0) return;
    Params p{};
    for (int i = 0; i < 21; ++i) p.in[i] = (const float*)d_in[i];
    p.out = (float*)d_out; p.ws = (unsigned char*)d_ws;
    if (hipMemsetAsync((char*)d_ws + WS_CTL, 0, CTL_ZERO_BYTES, stream) != hipSuccess) { fprintf(stderr, "kernel_launch: hipMemsetAsync failed\n"); return; }
    void* args[] = {&p};
    hipError_t e = hipLaunchCooperativeKernel((const void*)fwd_megakernel, dim3(grid_blocks), dim3(512), args, LDS_BYTES, stream);
    if (e != hipSuccess) fprintf(stderr, "cooperative launch failed: %s (grid %d)\n", hipGetErrorString(e), grid_blocks);
}
```

```cpp
#include <hip/hip_runtime.h>
#include <hip/hip_cooperative_groups.h>
#include <cstdio>
#include <cstdint>
namespace cg = cooperative_groups;
namespace pg8 {
#define PG8_LAS __attribute__((address_space(3)))
typedef unsigned short bf16_t;
typedef short bf16x8 __attribute__((ext_vector_type(8)));
typedef float f32x4 __attribute__((ext_vector_type(4)));
typedef unsigned u32x4 __attribute__((ext_vector_type(4)));
constexpr int BM = 256, BK = 64, HALF = 128, HTB = HALF * BK * 2  , STAGE_BYTES = 8 * HTB, NXCD = 8, WGM = 8;

__host__ __device__ __forceinline__ int lds_byte(int r, int c) { const int st = (r >> 4) * 2 + (c >> 5), rr = r & 15, cc = c & 31, ob = rr * 64 + cc * 2; return st * 1024 + (ob ^ (((ob >> 9) & 1) << 5)); }
__host__ __device__ __forceinline__ void stage_rc(int b, int& R, int& C) { const int st = b / 1024, sb = b % 1024, swz = sb ^ (((sb >> 9) & 1) << 5); R = (st >> 1) * 16 + swz / 64; C = (st & 1) * 32 + (swz % 64) / 2; }
__host__ __device__ __forceinline__ int perm32(int rho) { const int n = rho >> 4, i = rho & 15; return 8 * (i >> 2) + 4 * n + (i & 3); }

struct Unit { int pm, pn; };
struct Gemm { const bf16_t* A; const bf16_t* Bt; int M, N, K; };

struct StaticOrder {
    int nM, nN, nwg, G, c;
    __host__ __device__ void init(int M, int N, int G_, int c_) { nM = M / BM; nN = N / BM; nwg = nM * nN; G = G_; c = c_; }
    __host__ __device__ bool next(int i, Unit& u) const {
        const long L = (long)i * G + c; if (L >= nwg) return false;
        int wgid = (int)L; { const int q = nwg / NXCD, r = nwg % NXCD, xcd = wgid % NXCD, off = wgid / NXCD; wgid = (xcd < r ? xcd * (q + 1) : r * (q + 1) + (xcd - r) * q) + off; }
        const int nig = WGM * nN, gid = wgid / nig, fm = gid * WGM, gsz = (nM - fm) < WGM ? (nM - fm) : WGM;
        u.pm = fm + ((wgid % nig) % gsz); u.pn = (wgid % nig) / gsz; return true;
    }
    __device__ __forceinline__ void a_ready(const Unit&) const {}
    __device__ __forceinline__ void done(const Unit&) const {}
};

__device__ __forceinline__ unsigned cvt_pk_bf16(float lo, float hi) { unsigned r; asm volatile("v_cvt_pk_bf16_f32 %0, %1, %2" : "=v"(r) : "v"(lo), "v"(hi)); return r; }
typedef float f32x2 __attribute__((ext_vector_type(2)));
__device__ __forceinline__ f32x2 gelu_pk(f32x2 v) {
    const f32x2 av = __builtin_elementwise_abs(v), d = av * 0.2316418882f + 1.0f;
    f32x2 t; t.x = __builtin_amdgcn_rcpf(d.x); t.y = __builtin_amdgcn_rcpf(d.y);
    f32x2 q = t * 0.5307027145f + (-0.7265760135f); q = q * t + 0.7107068705f; q = q * t + (-0.142248368f); q = q * t + 0.127414796f; q = q * t;
    const f32x2 s = (v * v) * (-0.72134752044f);
    f32x2 e; e.x = __builtin_amdgcn_exp2f(s.x); e.y = __builtin_amdgcn_exp2f(s.y);
    const f32x2 m = v * (q * e), r = v - m;
    f32x2 o; o.x = v.x < 0.f ? m.x : r.x; o.y = v.y < 0.f ? m.y : r.y; return o;
}

template <int ACT  > struct EpiBf16 {
    static constexpr bool PERM = true, AFTER_DRAIN = false; static_assert(ACT >= 0 && ACT <= 2, "EpiBf16: ACT is 0 (none), 1 (gelu_pk) or 2 (squared relu)");
    bf16_t* O; int ldc; const float* bias; int split_cols; size_t split_stride; float scale0;
    __device__ __forceinline__ void operator()(const f32x4 (&acc)[2][2][4][2], const Unit& u, int wr, int wc, int fr, int fq) const {
        const int row0 = u.pm * BM + wr * 64 + fr; int colt = u.pn * BM; bf16_t* base = O;
        float sc = 1.f; if (split_cols) { const int t = colt / split_cols; base += (size_t)t * split_stride; colt -= t * split_cols; if (t == 0) sc = scale0; }
        const int col0 = colt + wc * 32 + 8 * fq, bcol0 = u.pn * BM + wc * 32 + 8 * fq;
        f32x4 bv[2][2];
#pragma unroll
        for (int bj = 0; bj < 2; ++bj)
#pragma unroll
            for (int n = 0; n < 2; ++n) bv[bj][n] = bias ? *(const f32x4*)(bias + bcol0 + bj * HALF + 4 * n) : (f32x4){0.f, 0.f, 0.f, 0.f};
#pragma unroll
        for (int ai = 0; ai < 2; ++ai)
#pragma unroll
            for (int m = 0; m < 4; ++m) { bf16_t* rowp = base + (size_t)(row0 + ai * HALF + m * 16) * ldc + col0;
#pragma unroll
                for (int bj = 0; bj < 2; ++bj) { f32x4 v0 = acc[ai][bj][m][0] + bv[bj][0], v1 = acc[ai][bj][m][1] + bv[bj][1];
                    if (ACT == 1) { f32x2 a = gelu_pk((f32x2){v0[0], v0[1]}), b = gelu_pk((f32x2){v0[2], v0[3]}), c = gelu_pk((f32x2){v1[0], v1[1]}), d = gelu_pk((f32x2){v1[2], v1[3]});
                        v0 = (f32x4){a.x, a.y, b.x, b.y}; v1 = (f32x4){c.x, c.y, d.x, d.y}; }
                    if (ACT == 2) { v0 = __builtin_elementwise_max(v0, (f32x4){0.f, 0.f, 0.f, 0.f}); v1 = __builtin_elementwise_max(v1, (f32x4){0.f, 0.f, 0.f, 0.f}); v0 = v0 * v0; v1 = v1 * v1; }
                    v0 = v0 * sc; v1 = v1 * sc; u32x4 w; w.x = cvt_pk_bf16(v0[0], v0[1]); w.y = cvt_pk_bf16(v0[2], v0[3]); w.z = cvt_pk_bf16(v1[0], v1[1]); w.w = cvt_pk_bf16(v1[2], v1[3]);
                    *(u32x4*)(rowp + bj * HALF) = w; } }
    }
};

struct PanelStats {
    unsigned* xbuf;
    unsigned* cnt;
    unsigned* tmo;
    int ntn; float eps;
    unsigned code;
    __device__ __forceinline__ bool run(const f32x4 (&v)[2][2][4][2], const Unit& u, int wr, int wc, int fr, int fq, PG8_LAS unsigned char* lds, int wid, int lane) const {
        typedef float f32x2v __attribute__((ext_vector_type(2)));
        PG8_LAS f32x2v* P = (PG8_LAS f32x2v*)lds;
        PG8_LAS f32x2v* S = (PG8_LAS f32x2v*)(lds + 8192);
        PG8_LAS unsigned* flag = (PG8_LAS unsigned*)(lds + 8192 + 2048);
#pragma unroll
        for (int ai = 0; ai < 2; ++ai)
#pragma unroll
            for (int m = 0; m < 4; ++m) {
                float s = 0.f;
#pragma unroll
                for (int bj = 0; bj < 2; ++bj)
#pragma unroll
                    for (int n = 0; n < 2; ++n) { const f32x4 x = v[ai][bj][m][n]; s += (x[0] + x[1]) + (x[2] + x[3]); }
                s += __shfl_xor(s, 16); s += __shfl_xor(s, 32);
                const float mw = s * (1.0f / 64.0f); float q = 0.f;
#pragma unroll
                for (int bj = 0; bj < 2; ++bj)
#pragma unroll
                    for (int n = 0; n < 2; ++n) { const f32x4 d = v[ai][bj][m][n] - mw; q += (d[0] * d[0] + d[1] * d[1]) + (d[2] * d[2] + d[3] * d[3]); }
                q += __shfl_xor(q, 16); q += __shfl_xor(q, 32);
                if (fq == 0) P[(ai * HALF + wr * 64 + m * 16 + fr) * 4 + wc] = (f32x2v){mw, q};
            }
        asm volatile("s_waitcnt lgkmcnt(0)" ::: "memory"); __builtin_amdgcn_s_barrier(); asm volatile("" ::: "memory");
#if defined(BROKEN_EXCHANGE_NO_WAIT)
#warning BROKEN CONTROL BUILD: the row-statistics exchange does not wait; results are wrong by design
        if (blockIdx.x >= 64) { const long long t0_ = clock64(); while (clock64() - t0_ < 60000) __builtin_amdgcn_s_sleep(8); }
#endif
        const int row = wid * 32 + (lane & 31);
        if (lane < 32) {
            const f32x2v a = P[row * 4 + 0], b = P[row * 4 + 1], c = P[row * 4 + 2], d = P[row * 4 + 3];
            const float mt = (a.x + b.x + c.x + d.x) * 0.25f;
            const float da = a.x - mt, db = b.x - mt, dc = c.x - mt, dd = d.x - mt;
            const float m2 = (a.y + b.y) + (c.y + d.y) + 64.0f * ((da * da + db * db) + (dc * dc + dd * dd));
            unsigned long long* slot = (unsigned long long*)xbuf + ((size_t)(u.pm * BM + row) * 4 + u.pn);
            __hip_atomic_store(slot, ((unsigned long long)__float_as_uint(m2) << 32) | __float_as_uint(mt), __ATOMIC_RELAXED, __HIP_MEMORY_SCOPE_AGENT);
        }
        asm volatile("s_waitcnt vmcnt(0)" ::: "memory");
        if (lane == 0) __hip_atomic_fetch_add(cnt + 64 * u.pm, 1u, __ATOMIC_RELAXED, __HIP_MEMORY_SCOPE_AGENT);
        if (wid == 0) {
            bool dead = false; const unsigned long long t0 = __builtin_amdgcn_s_memrealtime(); const unsigned want = 8u * (unsigned)ntn;
            for (;;) {
#if defined(BROKEN_EXCHANGE_NO_WAIT)
                break;
#endif
                if ((unsigned)__builtin_amdgcn_readfirstlane(__hip_atomic_load(cnt + 64 * u.pm, __ATOMIC_RELAXED, __HIP_MEMORY_SCOPE_AGENT)) >= want) break;
                if (__builtin_amdgcn_s_memrealtime() - t0 > 2000000ull) {
                    if (lane == 0) { unsigned expect = 0u; __hip_atomic_compare_exchange_strong(tmo + 1, &expect, code | (unsigned)(u.pm & 0xff), __ATOMIC_RELAXED, __ATOMIC_RELAXED, __HIP_MEMORY_SCOPE_AGENT);
                                     __hip_atomic_store(tmo, 1u, __ATOMIC_RELAXED, __HIP_MEMORY_SCOPE_AGENT); }
                    dead = true; break; }
                __builtin_amdgcn_s_sleep(2);
            }
            __builtin_amdgcn_fence(__ATOMIC_ACQUIRE, "agent");
            if (lane == 0) flag[0] = dead ? 1u : 0u;
        }
        asm volatile("s_waitcnt vmcnt(0) lgkmcnt(0)" ::: "memory"); __builtin_amdgcn_s_barrier(); asm volatile("" ::: "memory");
        const bool bad = flag[0] != 0u;
        if (lane < 32) {
            const unsigned long long* slot = (const unsigned long long*)xbuf + (size_t)(u.pm * BM + row) * 4; float mt[4], m2[4]; float ms = 0.f;
#pragma unroll
            for (int t = 0; t < 4; ++t) { if (t < ntn) { const unsigned long long w = __hip_atomic_load(slot + t, __ATOMIC_RELAXED, __HIP_MEMORY_SCOPE_AGENT); mt[t] = __uint_as_float((unsigned)w); m2[t] = __uint_as_float((unsigned)(w >> 32)); } else { mt[t] = 0.f; m2[t] = 0.f; } ms += mt[t]; }
            const float mean = ms / (float)ntn; float q = 0.f;
#pragma unroll
            for (int t = 0; t < 4; ++t) if (t < ntn) { const float dm = mt[t] - mean; q += m2[t] + 256.0f * dm * dm; }
            S[row] = (f32x2v){mean, 1.0f / sqrtf(q / (256.0f * (float)ntn) + eps)};
        }
        asm volatile("s_waitcnt lgkmcnt(0)" ::: "memory"); __builtin_amdgcn_s_barrier(); asm volatile("" ::: "memory");
        return bad;
    }
};
struct EpiLnRes {
    static constexpr bool PERM = false, AFTER_DRAIN = true;
    const float* base; float* out; int ldc; const float* bias; PanelStats st; unsigned poison;
    __device__ __forceinline__ void fused(f32x4 (&acc)[2][2][4][2], const Unit& u, int wr, int wc, int fr, int fq, PG8_LAS unsigned char* lds, int wid, int lane) const {
        typedef float f32x2v __attribute__((ext_vector_type(2)));
        const PG8_LAS f32x2v* S = (const PG8_LAS f32x2v*)(lds + 8192);
        const int col0 = u.pn * BM + wc * 32 + 4 * fq;
#pragma unroll
        for (int bj = 0; bj < 2; ++bj)
#pragma unroll
            for (int n = 0; n < 2; ++n) { const f32x4 bv = bias ? *(const f32x4*)(bias + col0 + bj * HALF + n * 16) : (f32x4){0.f, 0.f, 0.f, 0.f};
#pragma unroll
                for (int ai = 0; ai < 2; ++ai)
#pragma unroll
                    for (int m = 0; m < 4; ++m) acc[ai][bj][m][n] += bv; }
        f32x4 pre[4][2][2];
#pragma unroll
        for (int m = 0; m < 4; ++m) { const size_t off = (size_t)(u.pm * BM + wr * 64 + m * 16 + fr) * ldc + col0;
#pragma unroll
            for (int bj = 0; bj < 2; ++bj)
#pragma unroll
                for (int n = 0; n < 2; ++n) pre[m][bj][n] = *(const f32x4*)(base + off + bj * HALF + n * 16); }
        const bool bad = st.run(acc, u, wr, wc, fr, fq, lds, wid, lane) || poison != 0u;
        const float qnan = __builtin_nanf("");
#pragma unroll
        for (int ai = 0; ai < 2; ++ai)
#pragma unroll
            for (int m = 0; m < 4; ++m) { const int r = ai * HALF + wr * 64 + m * 16 + fr; const f32x2v sr = S[r]; const size_t off = (size_t)(u.pm * BM + r) * ldc + col0;
#pragma unroll
                for (int bj = 0; bj < 2; ++bj)
#pragma unroll
                    for (int n = 0; n < 2; ++n) { const f32x4 bs = ai == 0 ? pre[m][bj][n] : *(const f32x4*)(base + off + bj * HALF + n * 16); f32x4 o = bs + (acc[ai][bj][m][n] - sr.x) * sr.y;
                        if (bad) o = (f32x4){qnan, qnan, qnan, qnan}; *(f32x4*)(out + off + bj * HALF + n * 16) = o; }
                if (m & 1) asm volatile("" ::: "memory"); }
    }
};
struct EpiLnResLn {
    static constexpr bool PERM = false, AFTER_DRAIN = true;
    const float* base; float* out; bf16_t* xn; int ldc; const float* bias; PanelStats st1, st2; unsigned poison;
    __device__ __forceinline__ void fused(f32x4 (&acc)[2][2][4][2], const Unit& u, int wr, int wc, int fr, int fq, PG8_LAS unsigned char* lds, int wid, int lane) const {
        typedef float f32x2v __attribute__((ext_vector_type(2))); typedef unsigned u32x2v __attribute__((ext_vector_type(2)));
        const PG8_LAS f32x2v* S = (const PG8_LAS f32x2v*)(lds + 8192);
        const int col0 = u.pn * BM + wc * 32 + 4 * fq;
#pragma unroll
        for (int bj = 0; bj < 2; ++bj)
#pragma unroll
            for (int n = 0; n < 2; ++n) { const f32x4 bv = bias ? *(const f32x4*)(bias + col0 + bj * HALF + n * 16) : (f32x4){0.f, 0.f, 0.f, 0.f};
#pragma unroll
                for (int ai = 0; ai < 2; ++ai)
#pragma unroll
                    for (int m = 0; m < 4; ++m) acc[ai][bj][m][n] += bv; }
        bool bad = st1.run(acc, u, wr, wc, fr, fq, lds, wid, lane) || poison != 0u;
        const float qnan = __builtin_nanf("");
#pragma unroll
        for (int ai = 0; ai < 2; ++ai)
#pragma unroll
            for (int m = 0; m < 4; ++m) { const int r = ai * HALF + wr * 64 + m * 16 + fr; const f32x2v sr = S[r]; const size_t off = (size_t)(u.pm * BM + r) * ldc + col0;
#pragma unroll
                for (int bj = 0; bj < 2; ++bj)
#pragma unroll
                    for (int n = 0; n < 2; ++n) { const f32x4 bs = *(const f32x4*)(base + off + bj * HALF + n * 16); acc[ai][bj][m][n] = bs + (acc[ai][bj][m][n] - sr.x) * sr.y; }
                asm volatile("" : "+v"(acc[ai][0][m][0]), "+v"(acc[ai][0][m][1]), "+v"(acc[ai][1][m][0]), "+v"(acc[ai][1][m][1]));
                if (m & 1) asm volatile("" ::: "memory"); }
        const bool bad1 = bad;
        bad = st2.run(acc, u, wr, wc, fr, fq, lds, wid, lane) || bad;
#pragma unroll
        for (int ai = 0; ai < 2; ++ai)
#pragma unroll
            for (int m = 0; m < 4; ++m) { const int r = ai * HALF + wr * 64 + m * 16 + fr; const f32x2v sr = S[r]; const size_t off = (size_t)(u.pm * BM + r) * ldc + col0;
#pragma unroll
                for (int bj = 0; bj < 2; ++bj)
#pragma unroll
                    for (int n = 0; n < 2; ++n) { const f32x4 x1 = acc[ai][bj][m][n]; *(f32x4*)(out + off + bj * HALF + n * 16) = bad1 ? (f32x4){qnan, qnan, qnan, qnan} : x1;
                        const f32x4 o = (x1 - sr.x) * sr.y; u32x2v w; w.x = cvt_pk_bf16(o[0], o[1]); w.y = cvt_pk_bf16(o[2], o[3]);
                        if (bad) { w.x = 0x7fc07fc0u; w.y = 0x7fc07fc0u; } *(u32x2v*)(xn + off + bj * HALF + n * 16) = w; }
                asm volatile("" ::: "memory"); }
    }
};

template <class Epi, class Sched, bool ALIGN_EPI = false, bool SP2 = false>
__device__ __forceinline__ void gemm_phase(PG8_LAS unsigned char* lds, const Gemm g, const Sched& S, const Epi& E) {
    int tid_l = threadIdx.x; asm volatile("" : "+v"(tid_l)); const int tid = tid_l, wid = __builtin_amdgcn_readfirstlane(tid >> 6), lane = tid & 63, wr = wid >> 2, wc = wid & 3, fr = lane & 15, fq = lane >> 4;
    const int K = g.K, nt = K / BK;
    unsigned voffA[2], voffB[2];
#pragma unroll
    for (int i = 0; i < 2; ++i) { int R, C; stage_rc(tid * 16 + i * 8192, R, C); const int Rb = Epi::PERM ? ((R & ~31) + perm32(R & 31)) : R;
        voffA[i] = (unsigned)(R * K + C) * 2u; voffB[i] = (unsigned)(Rb * K + C) * 2u; }
    const size_t kstep = (size_t)(BK * 2);
    const size_t hstep = (size_t)HALF * K * 2;
    const size_t tstep = 2 * hstep;
    const unsigned ldsw = (unsigned)wid * 1024u;
    const int aoff = lds_byte(wr * 64 + fr, fq * 8), boff = lds_byte(wc * 32 + fr, fq * 8);
#define PG8_SA(b, h) (((b) * 2 + (h)) * HTB)
#define PG8_SB(b, h) ((4 + (b) * 2 + (h)) * HTB)
#define PG8_STAGE(bufoff, gbase, voff) do { _Pragma("unroll") for (int _i = 0; _i < 2; ++_i) \
        __builtin_amdgcn_global_load_lds((const unsigned*)((const char*)(gbase) + (voff)[_i]), (PG8_LAS unsigned*)(lds + (bufoff) + ldsw + _i * 8192), 16, 0, 0); } while (0)
#define PG8_LDA(dst, b, h) do { _Pragma("unroll") for (int m = 0; m < 4; ++m) _Pragma("unroll") for (int k = 0; k < 2; ++k) dst[m][k] = *(const PG8_LAS bf16x8*)(lds + PG8_SA(b, h) + aoff + m * 2048 + k * 1024); } while (0)
#define PG8_LDB(dst, b, h) do { _Pragma("unroll") for (int n = 0; n < 2; ++n) _Pragma("unroll") for (int k = 0; k < 2; ++k) dst[n][k] = *(const PG8_LAS bf16x8*)(lds + PG8_SB(b, h) + boff + n * 2048 + k * 1024); } while (0)
#define PG8_MMA(ai, bj, At, Bt) do { __builtin_amdgcn_s_setprio(1); _Pragma("unroll") for (int m = 0; m < 4; ++m) _Pragma("unroll") for (int n = 0; n < 2; ++n) _Pragma("unroll") for (int k = 0; k < 2; ++k) \
        acc[ai][bj][m][n] = __builtin_amdgcn_mfma_f32_16x16x32_bf16(Bt[n][k], At[m][k], acc[ai][bj][m][n], 0, 0, 0); __builtin_amdgcn_s_setprio(0); } while (0)
#define PG8_WAIT_V(n) asm volatile("s_waitcnt vmcnt(" #n ")" ::: "memory")
#define PG8_WAIT_L(n) asm volatile("s_waitcnt lgkmcnt(" #n ")" ::: "memory")
#define PG8_BAR __builtin_amdgcn_s_barrier()
#define PG8_SCHED __builtin_amdgcn_sched_barrier(0)
    Unit cur, nxt; int ui = 0;
    if (!S.next(0, cur)) return;
    f32x4 acc[2][2][4][2];
#pragma unroll
    for (int a = 0; a < 2; ++a)
#pragma unroll
        for (int b = 0; b < 2; ++b)
#pragma unroll
            for (int m = 0; m < 4; ++m)
#pragma unroll
                for (int n = 0; n < 2; ++n) acc[a][b][m][n] = (f32x4){0.f, 0.f, 0.f, 0.f};
    bf16x8 At[4][2], B0[2][2], B1[2][2];
    const char* cA = (const char*)g.A + (size_t)cur.pm * tstep; const char* cB = (const char*)g.Bt + (size_t)cur.pn * tstep;
    S.a_ready(cur);
    if constexpr (SP2) {
        PG8_STAGE(PG8_SB(0, 0), cB, voffB); PG8_STAGE(PG8_SB(0, 1), cB + hstep, voffB); PG8_STAGE(PG8_SA(0, 0), cA, voffA); PG8_STAGE(PG8_SA(0, 1), cA + hstep, voffA);
        if (wr == 1) PG8_BAR;
        PG8_WAIT_V(2); PG8_BAR;
        PG8_STAGE(PG8_SB(1, 0), cB + kstep, voffB); PG8_STAGE(PG8_SA(1, 0), cA + kstep, voffA); PG8_STAGE(PG8_SB(1, 1), cB + hstep + kstep, voffB);
        PG8_WAIT_V(6); PG8_BAR;
    } else {
        PG8_STAGE(PG8_SB(0, 0), cB, voffB); PG8_STAGE(PG8_SA(0, 0), cA, voffA); PG8_STAGE(PG8_SB(0, 1), cB + hstep, voffB); PG8_STAGE(PG8_SA(0, 1), cA + hstep, voffA);
        if (wr == 1) PG8_BAR;
        PG8_WAIT_V(4); PG8_BAR;
        PG8_STAGE(PG8_SB(1, 0), cB + kstep, voffB); PG8_STAGE(PG8_SA(1, 0), cA + kstep, voffA); PG8_STAGE(PG8_SB(1, 1), cB + hstep + kstep, voffB);
        PG8_WAIT_V(6); PG8_BAR;
    }
    for (;;) {
        const bool has_next = S.next(ui + 1, nxt);
        const char* nA = has_next ? (const char*)g.A + (size_t)nxt.pm * tstep : cA; const char* nB = has_next ? (const char*)g.Bt + (size_t)nxt.pn * tstep : cB;
        for (int t = 0; t < nt; t += 2) {
            const bool last = (t == nt - 2);
            const char* a1 = cA + (size_t)(t + 1) * kstep;
            const char* a2 = last ? nA : cA + (size_t)(t + 2) * kstep; const char* b2 = last ? nB : cB + (size_t)(t + 2) * kstep;
            const char* a3 = a2 + kstep; const char* b3 = b2 + kstep;
            if (last && has_next) S.a_ready(nxt);
            if constexpr (SP2) {
            PG8_LDB(B0, 0, 0); PG8_LDB(B1, 0, 1); PG8_SCHED; PG8_LDA(At, 0, 0); PG8_STAGE(PG8_SA(1, 1), a1 + hstep, voffA);
            PG8_WAIT_V(8); PG8_WAIT_L(0); PG8_BAR; PG8_MMA(0, 0, At, B0); PG8_MMA(0, 1, At, B1); PG8_BAR; PG8_SCHED;
            PG8_LDA(At, 0, 1); PG8_STAGE(PG8_SB(0, 0), b2, voffB); PG8_STAGE(PG8_SB(0, 1), b2 + hstep, voffB); PG8_STAGE(PG8_SA(0, 0), a2, voffA);
            PG8_WAIT_V(8); PG8_WAIT_L(0); PG8_BAR; PG8_MMA(1, 0, At, B0); PG8_MMA(1, 1, At, B1); PG8_BAR; PG8_SCHED;
            PG8_LDB(B0, 1, 0); PG8_LDB(B1, 1, 1); PG8_SCHED; PG8_LDA(At, 1, 0); PG8_STAGE(PG8_SA(0, 1), a2 + hstep, voffA);
            PG8_WAIT_V(8); PG8_WAIT_L(0); PG8_BAR; PG8_MMA(0, 0, At, B0); PG8_MMA(0, 1, At, B1); PG8_BAR; PG8_SCHED;
            PG8_LDA(At, 1, 1); PG8_STAGE(PG8_SB(1, 0), b3, voffB); PG8_STAGE(PG8_SB(1, 1), b3 + hstep, voffB); PG8_STAGE(PG8_SA(1, 0), a3, voffA);
            PG8_WAIT_V(8); PG8_WAIT_L(0); PG8_BAR; PG8_MMA(1, 0, At, B0); PG8_MMA(1, 1, At, B1); PG8_BAR; PG8_SCHED;
            } else {
            PG8_LDB(B0, 0, 0); PG8_SCHED; PG8_LDA(At, 0, 0); PG8_STAGE(PG8_SA(1, 1), a1 + hstep, voffA);
            PG8_WAIT_L(8); PG8_BAR; PG8_WAIT_L(0); PG8_MMA(0, 0, At, B0); PG8_BAR; PG8_SCHED;
            PG8_LDB(B1, 0, 1); PG8_STAGE(PG8_SB(0, 0), b2, voffB);
            PG8_BAR; PG8_WAIT_L(0); PG8_MMA(0, 1, At, B1); PG8_BAR;
            PG8_LDA(At, 0, 1); PG8_STAGE(PG8_SA(0, 0), a2, voffA);
            PG8_BAR; PG8_WAIT_L(0); PG8_MMA(1, 0, At, B0); PG8_BAR; PG8_SCHED;
            PG8_STAGE(PG8_SB(0, 1), b2 + hstep, voffB);
            PG8_WAIT_V(6); PG8_BAR; PG8_MMA(1, 1, At, B1); PG8_BAR;
            PG8_LDB(B0, 1, 0); PG8_SCHED; PG8_LDA(At, 1, 0); PG8_STAGE(PG8_SA(0, 1), a2 + hstep, voffA);
            PG8_WAIT_L(8); PG8_BAR; PG8_WAIT_L(0); PG8_MMA(0, 0, At, B0); PG8_BAR; PG8_SCHED;
            PG8_LDB(B1, 1, 1); PG8_STAGE(PG8_SB(1, 0), b3, voffB);
            PG8_BAR; PG8_WAIT_L(0); PG8_MMA(0, 1, At, B1); PG8_BAR;
            PG8_LDA(At, 1, 1); PG8_STAGE(PG8_SA(1, 0), a3, voffA);
            PG8_BAR; PG8_WAIT_L(0); PG8_MMA(1, 0, At, B0); PG8_BAR; PG8_SCHED;
            PG8_STAGE(PG8_SB(1, 1), b3 + hstep, voffB);
            PG8_WAIT_V(6); PG8_BAR; PG8_MMA(1, 1, At, B1); PG8_BAR;
            }
        }
        if constexpr (ALIGN_EPI) { if (wr == 0) PG8_BAR; }
        if constexpr (!Epi::AFTER_DRAIN) { E(acc, cur, wr, wc, fr, fq); S.done(cur); }
        if (!has_next) break;
#pragma unroll
        for (int a = 0; a < 2; ++a)
#pragma unroll
            for (int b = 0; b < 2; ++b)
#pragma unroll
                for (int m = 0; m < 4; ++m)
#pragma unroll
                    for (int n = 0; n < 2; ++n) acc[a][b][m][n] = (f32x4){0.f, 0.f, 0.f, 0.f};
        cur = nxt; cA = nA; cB = nB; ++ui;
        if constexpr (ALIGN_EPI) { if (wr == 1) PG8_BAR; }
    }
    PG8_WAIT_V(0);
    if constexpr (!ALIGN_EPI) { if (wr == 0) PG8_BAR; }
    PG8_BAR;
    if constexpr (Epi::AFTER_DRAIN) { E.fused(acc, cur, wr, wc, fr, fq, lds, wid, lane); S.done(cur); }
#undef PG8_SA
#undef PG8_SB
#undef PG8_STAGE
#undef PG8_LDA
#undef PG8_LDB
#undef PG8_MMA
#undef PG8_WAIT_V
#undef PG8_WAIT_L
#undef PG8_BAR
#undef PG8_SCHED
}
}

namespace pg8 {
struct EpiRes {
    static constexpr bool PERM = false, AFTER_DRAIN = false;
    float* io; int ldc; float alpha;
    __device__ __forceinline__ void operator()(const f32x4 (&acc)[2][2][4][2], const Unit& u, int wr, int wc, int fr, int fq) const {
        const int col0 = u.pn * BM + wc * 32 + 4 * fq;
#pragma unroll
        for (int ai = 0; ai < 2; ++ai)
#pragma unroll
            for (int m = 0; m < 4; ++m) { float* rp = io + (size_t)(u.pm * BM + ai * HALF + wr * 64 + m * 16 + fr) * ldc + col0;
#pragma unroll
                for (int bj = 0; bj < 2; ++bj)
#pragma unroll
                    for (int n = 0; n < 2; ++n) { f32x4* p = (f32x4*)(rp + bj * HALF + n * 16); const f32x4 o = *p; *p = o * alpha + acc[ai][bj][m][n]; } }
    }
};
}

constexpr int BATCH = 4, SEQ = 4096, DM = 1024, DEPTH = 2, HD = 64, GW = 256, NH = 4, DIN = 3328, DFF = 4096, M = BATCH * SEQ;
constexpr float LN_EPS = 1e-5f, NORM_EPS = 1e-6f;
constexpr float ALPHA = 1.41421356237309515f;
constexpr int NCH = SEQ / 128;
constexpr int NITEM = BATCH * NH * NCH;

constexpr size_t MiB = 1u << 20;
constexpr size_t W_IN_B = (size_t)DIN * DM * 2, W_OUT_B = (size_t)DM * DM * 2, W_UP_B = (size_t)DFF * DM * 2, W_DN_B = (size_t)DM * DFF * 2;
constexpr size_t W_LAYER_B = W_IN_B + W_OUT_B + W_UP_B + W_DN_B;
constexpr size_t WS_W = 0;
constexpr size_t WS_CTL = 50 * MiB, CTL_ZERO_BYTES = 1 * MiB;
constexpr int CW_BAR = 4096;
constexpr size_t WS_XN = 52 * MiB;
constexpr size_t WS_PROJ = 84 * MiB;
constexpr size_t WS_Y = 188 * MiB;
constexpr size_t WS_U = 84 * MiB;
constexpr size_t WS_KVB = 220 * MiB;
constexpr size_t WS_KVD = 228 * MiB;
constexpr size_t WS_DVEC = 236 * MiB;
constexpr size_t WS_ASUM = 236 * MiB + 256 * 1024;
constexpr size_t WS_LB = 236 * MiB + 768 * 1024;
constexpr size_t WS_ROPE = 237 * MiB;
constexpr size_t WS_END = 238 * MiB;
static_assert(2 * W_LAYER_B <= WS_XN, "weights fit");

constexpr int LDS_BYTES = 147456;

typedef unsigned short bf16;
typedef unsigned v4u __attribute__((ext_vector_type(4)));
typedef unsigned v2u __attribute__((ext_vector_type(2)));
typedef float f32x4 __attribute__((ext_vector_type(4)));
typedef short bf16x8 __attribute__((ext_vector_type(8)));
#define LAS __attribute__((address_space(3)))
#define MFMA16(a, b, c) __builtin_amdgcn_mfma_f32_16x16x32_bf16((a), (b), (c), 0, 0, 0)

typedef float f32x2_ __attribute__((ext_vector_type(2)));
typedef __bf16 bf16x2_ __attribute__((ext_vector_type(2)));
__device__ __forceinline__ unsigned pk2(float lo, float hi) { f32x2_ v = {lo, hi}; bf16x2_ b = __builtin_convertvector(v, bf16x2_); return __builtin_bit_cast(unsigned, b); }
__device__ __forceinline__ float bflo(unsigned u) { return __uint_as_float(u << 16); }
__device__ __forceinline__ float bfhi(unsigned u) { return __uint_as_float(u & 0xffff0000u); }
__device__ __forceinline__ float bf1(bf16 u) { return __uint_as_float(((unsigned)u) << 16); }
__device__ __forceinline__ bf16 f2bf(float f) { return (bf16)(pk2(f, 0.f) & 0xffffu); }
__device__ __forceinline__ bf16x8 pack8(const float (&v)[8]) {
    v4u w; w.x = pk2(v[0], v[1]); w.y = pk2(v[2], v[3]); w.z = pk2(v[4], v[5]); w.w = pk2(v[6], v[7]);
    return __builtin_bit_cast(bf16x8, w);
}
__device__ __forceinline__ void unpack8(v4u w, float (&v)[8]) {
    v[0] = bflo(w.x); v[1] = bfhi(w.x); v[2] = bflo(w.y); v[3] = bfhi(w.y); v[4] = bflo(w.z); v[5] = bfhi(w.z); v[6] = bflo(w.w); v[7] = bfhi(w.w);
}
__device__ __forceinline__ float wave_sum(float v) {
#pragma unroll
    for (int o = 1; o < 64; o <<= 1) v += __shfl_xor(v, o);
    return v;
}
__device__ __forceinline__ float sigmoidf_(float x) { return __builtin_amdgcn_rcpf(1.f + __expf(-x)); }
__device__ __forceinline__ float siluf_(float x) { return x * sigmoidf_(x); }
__device__ __forceinline__ float gelu_tanh_(float x) { const float u = 0.7978845608028654f * (x + 0.044715f * x * x * x); const float t = 1.f - 2.f * __builtin_amdgcn_rcpf(1.f + __expf(2.f * u)); return 0.5f * x * (1.f + t); }
__device__ __forceinline__ float softplusf_(float z) { return fmaxf(z, 0.f) + __logf(1.f + __expf(-fabsf(z))); }

struct Params {
    const float* in[21];
    float* out;
    unsigned char* ws;
};

__device__ __forceinline__ void p0_transpose_item(const float* W, int K, int N, bf16* WT, float* scr, int item, int lane) {
    const int nblk = N / 32, kb = item / nblk, nb = item % nblk, k0 = 64 * kb, n0 = 32 * nb;
#pragma unroll 8
    for (int i = 0; i < 32; ++i) { const int kk = 2 * i + (lane >> 5); scr[kk * 33 + (lane & 31)] = W[(size_t)(k0 + kk) * N + n0 + (lane & 31)]; }
    asm volatile("s_waitcnt lgkmcnt(0)" ::: "memory");
    const int c = lane & 7;
#pragma unroll
    for (int j = 0; j < 4; ++j) { const int n = (lane >> 3) + 8 * j; const float* s = scr + (8 * c) * 33 + n;
        v4u o; o.x = pk2(s[0 * 33], s[1 * 33]); o.y = pk2(s[2 * 33], s[3 * 33]); o.z = pk2(s[4 * 33], s[5 * 33]); o.w = pk2(s[6 * 33], s[7 * 33]);
        *(v4u*)(WT + (size_t)(n0 + n) * K + k0 + 8 * c) = o; }
    asm volatile("s_waitcnt lgkmcnt(0)" ::: "memory");
}
__device__ __forceinline__ void ln_row(const float* src, const float* g, const float* b, float* dstf, bf16* dstb, int lane) {
    const f32x4* xr = (const f32x4*)src + lane;
    f32x4 v[4]; float s = 0.f;
#pragma unroll
    for (int j = 0; j < 4; ++j) { v[j] = xr[64 * j]; s += (v[j].x + v[j].y) + (v[j].z + v[j].w); }
    const float mean = wave_sum(s) * (1.f / DM); float s2 = 0.f;
#pragma unroll
    for (int j = 0; j < 4; ++j) { v[j] = v[j] - mean; s2 += (v[j].x * v[j].x + v[j].y * v[j].y) + (v[j].z * v[j].z + v[j].w * v[j].w); }
    const float rstd = 1.f / sqrtf(wave_sum(s2) * (1.f / DM) + LN_EPS);
#pragma unroll
    for (int j = 0; j < 4; ++j) {
        const f32x4 gg = ((const f32x4*)g)[lane + 64 * j], bb = ((const f32x4*)b)[lane + 64 * j];
        const f32x4 o = v[j] * rstd * gg + bb;
        ((f32x4*)dstf)[lane + 64 * j] = o;
        v2u w; w.x = pk2(o.x, o.y); w.y = pk2(o.z, o.w);
        ((v2u*)dstb)[lane + 64 * j] = w;
    }
}
__device__ __forceinline__ void ln_phase(const float* g, const float* b, float* io, bf16* xn, int gw, int ngw, int lane) {
    f32x4 gg[4], bb[4];
#pragma unroll
    for (int j = 0; j < 4; ++j) { gg[j] = ((const f32x4*)g)[lane + 64 * j]; bb[j] = ((const f32x4*)b)[lane + 64 * j]; }
    for (int m0 = gw; m0 < M; m0 += 4 * ngw) {
        f32x4 v[4][4];
#pragma unroll
        for (int r = 0; r < 4; ++r) { const int m = m0 + r * ngw; const f32x4* xr = (const f32x4*)(io + (size_t)(m < M ? m : m0) * DM) + lane;
#pragma unroll
            for (int j = 0; j < 4; ++j) v[r][j] = xr[64 * j]; }
#pragma unroll
        for (int r = 0; r < 4; ++r) {
            const int m = m0 + r * ngw;
            float s = 0.f;
#pragma unroll
            for (int j = 0; j < 4; ++j) s += (v[r][j].x + v[r][j].y) + (v[r][j].z + v[r][j].w);
            const float mean = wave_sum(s) * (1.f / DM); float s2 = 0.f;
#pragma unroll
            for (int j = 0; j < 4; ++j) { v[r][j] = v[r][j] - mean; s2 += (v[r][j].x * v[r][j].x + v[r][j].y * v[r][j].y) + (v[r][j].z * v[r][j].z + v[r][j].w * v[r][j].w); }
            const float rstd = 1.f / sqrtf(wave_sum(s2) * (1.f / DM) + LN_EPS);
            if (m < M) {
#pragma unroll
                for (int j = 0; j < 4; ++j) {
                    const f32x4 o = v[r][j] * rstd * gg[j] + bb[j];
                    ((f32x4*)(io + (size_t)m * DM))[lane + 64 * j] = o;
                    v2u w; w.x = pk2(o.x, o.y); w.y = pk2(o.z, o.w);
                    ((v2u*)(xn + (size_t)m * DM))[lane + 64 * j] = w;
                }
            }
        }
    }
}

__device__ __forceinline__ void prologue(const Params& p, unsigned char* lds, int tid) {
    const int lane = tid & 63, wave = tid >> 6;
    const int gw = blockIdx.x * 8 + wave, ngw = gridDim.x * 8;
    float* scr = (float*)(lds + wave * 16384);
    constexpr int I_IN = (DM / 64) * (DIN / 32), I_OUT = (DM / 64) * (DM / 32), I_UP = (DM / 64) * (DFF / 32), I_DN = (DFF / 64) * (DM / 32);
    constexpr int I_L = I_IN + I_OUT + I_UP + I_DN;
    for (int it = gw; it < DEPTH * I_L; it += ngw) {
        const int l = it / I_L; int r = it % I_L;
        bf16* wb = (bf16*)(p.ws + WS_W + (size_t)l * W_LAYER_B);
        if (r < I_IN) { p0_transpose_item(p.in[3] + (size_t)l * DM * DIN, DM, DIN, wb, scr, r, lane); continue; } r -= I_IN;
        if (r < I_OUT) { p0_transpose_item(p.in[14] + (size_t)l * DM * DM, DM, DM, wb + (size_t)DIN * DM, scr, r, lane); continue; } r -= I_OUT;
        if (r < I_UP) { p0_transpose_item(p.in[17] + (size_t)l * DM * DFF, DM, DFF, wb + (size_t)DIN * DM + (size_t)DM * DM, scr, r, lane); continue; } r -= I_UP;
        p0_transpose_item(p.in[18] + (size_t)l * DFF * DM, DFF, DM, wb + (size_t)DIN * DM + (size_t)DM * DM + (size_t)DFF * DM, scr, r, lane);
    }
    for (int m = gw; m < M; m += ngw) ln_row(p.in[0] + (size_t)m * DM, p.in[1], p.in[2], p.out + (size_t)m * DM, (bf16*)(p.ws + WS_XN) + (size_t)m * DM, lane);
#if defined(MK_ZERO_DIAG)
    { v4u* z = (v4u*)(p.ws + WS_Y); const size_t n = (WS_LB - WS_Y) / 16; for (size_t i = (size_t)blockIdx.x * 512 + tid; i < n; i += (size_t)gridDim.x * 512) z[i] = (v4u){0u, 0u, 0u, 0u}; }
#endif
    {
        float* rc = (float*)(p.ws + WS_ROPE); float* rs = rc + SEQ * 32;
        for (int i = blockIdx.x * 512 + tid; i < SEQ * 32; i += gridDim.x * 512) {
            const int pos = i >> 5, f = i & 31;
            const float inv = powf(10000.f, -(float)(2 * f) / 64.f);
            const float ang = (float)pos * inv;
            const float n = rintf(ang * 0.15915494309189535f);
            float r = fmaf(-n, 6.2831854820251465f, ang); r = fmaf(-n, -1.7484555e-7f, r);
            rc[i] = __cosf(r); rs[i] = __sinf(r);
        }
    }
    if (blockIdx.x == 0 && tid < GW) {
        const float* lg = p.in[12]; float* lb = (float*)(p.ws + WS_LB);
        float mx = lg[tid]; for (int l = 1; l < DEPTH; ++l) mx = fmaxf(mx, lg[l * GW + tid]);
        float den = 0.f; for (int l = 0; l < DEPTH; ++l) den += expf(lg[l * GW + tid] - mx);
        const float p0 = expf(lg[tid] - mx) / den; float cum = 0.f;
        for (int l = 0; l < DEPTH; ++l) { cum += expf(lg[l * GW + tid] - mx) / den; lb[l * GW + tid] = cum - p0; }
    }
}

constexpr int L_KS = 0;
constexpr int L_VT = 18432;
constexpr int L_ST = 35840;
constexpr int L_BS = 45056;
constexpr int L_KF = 79872;
constexpr int L_TOT = 114688;
constexpr int L_FLAG = 120000;
constexpr int L_WAT = 18432, L_WXT = 27648, L_AS = 36864, L_US = 71680, L_SEGA = 106496, L_SEGH = 108544;

struct VtRegs { v4u a, c; };
__device__ __forceinline__ VtRegs vt_load(const bf16* Vg, int tid) {
    const int s = tid & 127, eg = tid >> 7;
    const bf16* src = Vg + (size_t)s * DIN + 16 * eg;
    VtRegs r; r.a = *(const v4u*)src; r.c = *(const v4u*)(src + 8); return r;
}
__device__ __forceinline__ void vt_store(bf16* Vt, const VtRegs& r, int tid) {
    const int s = tid & 127, eg = tid >> 7;
    const v4u a = r.a, c = r.c;
    bf16* vt = Vt + (16 * eg) * 136 + s;
    vt[0 * 136] = (bf16)(a.x & 0xffffu); vt[1 * 136] = (bf16)(a.x >> 16); vt[2 * 136] = (bf16)(a.y & 0xffffu); vt[3 * 136] = (bf16)(a.y >> 16);
    vt[4 * 136] = (bf16)(a.z & 0xffffu); vt[5 * 136] = (bf16)(a.z >> 16); vt[6 * 136] = (bf16)(a.w & 0xffffu); vt[7 * 136] = (bf16)(a.w >> 16);
    vt[8 * 136] = (bf16)(c.x & 0xffffu); vt[9 * 136] = (bf16)(c.x >> 16); vt[10 * 136] = (bf16)(c.y & 0xffffu); vt[11 * 136] = (bf16)(c.y >> 16);
    vt[12 * 136] = (bf16)(c.z & 0xffffu); vt[13 * 136] = (bf16)(c.z >> 16); vt[14 * 136] = (bf16)(c.w & 0xffffu); vt[15 * 136] = (bf16)(c.w >> 16);
}
__device__ __forceinline__ bf16x8 vt_frag2(const bf16* Vt, int e, int lo, int hi, int q4) {
    const v2u a = *(const v2u*)(Vt + e * 136 + 16 * lo + 4 * q4), c = *(const v2u*)(Vt + e * 136 + 16 * hi + 4 * q4);
    v4u w; w.x = a.x; w.y = a.y; w.z = c.x; w.w = c.y; return __builtin_bit_cast(bf16x8, w);
}
__device__ __forceinline__ void kv_product(const bf16* Kt, const bf16* Vt, float* out, int w, int c16, int q4) {
    const int dt = w >> 1, et0 = 2 * (w & 1);
    f32x4 acc[2] = {{0.f, 0.f, 0.f, 0.f}, {0.f, 0.f, 0.f, 0.f}};
#pragma unroll
    for (int ks = 0; ks < 4; ++ks) {
        const bf16x8 a = *(const bf16x8*)(Kt + (16 * dt + c16) * 136 + 32 * ks + 8 * q4);
#pragma unroll
        for (int e2 = 0; e2 < 2; ++e2) { const bf16x8 b = *(const bf16x8*)(Vt + (16 * (et0 + e2) + c16) * 136 + 32 * ks + 8 * q4); acc[e2] = MFMA16(a, b, acc[e2]); }
    }
#pragma unroll
    for (int e2 = 0; e2 < 2; ++e2)
#pragma unroll
        for (int r = 0; r < 4; ++r) out[(16 * dt + 4 * q4 + r) * 64 + 16 * (et0 + e2) + c16] = acc[e2][r];
}

__device__ __forceinline__ void c_tile(const bf16* Ks, const bf16x8 (&Qf)[2], int j, int sbase, int tq, int lane, int c16, int q4, float& R, float (&wv)[4]) {
    const bf16x8 k0 = *(const bf16x8*)(Ks + (16 * j + c16) * 72 + 8 * q4), k1 = *(const bf16x8*)(Ks + (16 * j + c16) * 72 + 32 + 8 * q4);
    f32x4 z = {0.f, 0.f, 0.f, 0.f};
    z = MFMA16(k0, Qf[0], z); z = MFMA16(k1, Qf[1], z);
    float lk[4], ls[4]; bool valid[4];
#pragma unroll
    for (int r = 0; r < 4; ++r) { const float zz = z[r] * 0.125f; valid[r] = (sbase + 16 * j + 4 * q4 + r) < tq; const float sp = softplusf_(zz); lk[r] = valid[r] ? -sp : 0.f; ls[r] = zz - sp; }
    const float suf2 = lk[3], suf1 = suf2 + lk[2], suf0 = suf1 + lk[1], T = suf0 + lk[0];
    const float t1 = __shfl(T, (lane + 16) & 63), t2 = __shfl(T, (lane + 32) & 63), t3 = __shfl(T, (lane + 48) & 63);
    const float X = (q4 < 3 ? t1 : 0.f) + (q4 < 2 ? t2 : 0.f) + (q4 < 1 ? t3 : 0.f);
    float tot = T + __shfl_xor(T, 16); tot += __shfl_xor(tot, 32);
    const float base = R + X;
    wv[0] = valid[0] ? __expf(ls[0] + base + suf0) : 0.f;
    wv[1] = valid[1] ? __expf(ls[1] + base + suf1) : 0.f;
    wv[2] = valid[2] ? __expf(ls[2] + base + suf2) : 0.f;
    wv[3] = valid[3] ? __expf(ls[3] + base) : 0.f;
    R += tot;
}
__device__ __forceinline__ void mixer_c_item(unsigned char* lds, const bf16* proj, bf16* Y, int item, int tid_in) {
    int tid = tid_in; asm volatile("" : "+v"(tid));
    const int lane = tid & 63, w = __builtin_amdgcn_readfirstlane(tid >> 6), c16 = lane & 15, q4 = lane >> 4;
    const int qb = 31 - (item & 31), bh = item >> 5, b = bh >> 2, h = bh & 3;
    const size_t row0 = (size_t)b * SEQ;
    const bf16* Qg = proj + 6 * GW + h * HD; const bf16* Kg = proj + 7 * GW + h * HD; const bf16* Vg = proj + 8 * GW + h * HD;
    bf16* Ks = (bf16*)(lds + L_KS); bf16* Vt = (bf16*)(lds + L_VT); volatile unsigned* flags = (volatile unsigned*)(lds + L_FLAG);
    const int tq = qb * 128 + 16 * w + c16;
    bf16x8 Qf[2];
    Qf[0] = *(const bf16x8*)(Qg + (row0 + tq) * DIN + 8 * q4); Qf[1] = *(const bf16x8*)(Qg + (row0 + tq) * DIN + 32 + 8 * q4);
    f32x4 accO[4];
#pragma unroll
    for (int et = 0; et < 4; ++et) accO[et] = (f32x4){0.f, 0.f, 0.f, 0.f};
    float R = 0.f; bool done = false;
    const int ks_s = tid >> 2, ks_part = tid & 3;
    v4u kra, krc; VtRegs vr;
    { const bf16* src = Kg + (row0 + qb * 128 + ks_s) * DIN + 16 * ks_part; kra = *(const v4u*)src; krc = *(const v4u*)(src + 8); vr = vt_load(Vg + (row0 + qb * 128) * DIN, tid); }
    __syncthreads();
    for (int kb = qb; kb >= 0; --kb) {
        *(v4u*)(Ks + ks_s * 72 + 16 * ks_part) = kra; *(v4u*)(Ks + ks_s * 72 + 16 * ks_part + 8) = krc;
        vt_store(Vt, vr, tid);
        __syncthreads();
        if (kb > 0) { const bf16* src = Kg + (row0 + (kb - 1) * 128 + ks_s) * DIN + 16 * ks_part; kra = *(const v4u*)src; krc = *(const v4u*)(src + 8); vr = vt_load(Vg + (row0 + (kb - 1) * 128) * DIN, tid); }
        if (!done) {
            const int ptop = (kb == qb) ? (w >> 1) : 3;
            for (int pp = ptop; pp >= 0; --pp) {
                float wh[4], wl[4];
                c_tile(Ks, Qf, 2 * pp + 1, kb * 128, tq, lane, c16, q4, R, wh);
                c_tile(Ks, Qf, 2 * pp, kb * 128, tq, lane, c16, q4, R, wl);
                const float pv[8] = {wl[0], wl[1], wl[2], wl[3], wh[0], wh[1], wh[2], wh[3]};
                const bf16x8 P = pack8(pv);
#pragma unroll
                for (int et = 0; et < 4; ++et) accO[et] = MFMA16(vt_frag2(Vt, 16 * et + c16, 2 * pp, 2 * pp + 1, q4), P, accO[et]);
                if (__all(R < -104.f)) { done = true; break; }
            }
        }
        if (lane == 0) flags[w] = done ? 1u : 0u;
        __syncthreads();
        unsigned alld = 1u;
#pragma unroll
        for (int i = 0; i < 8; ++i) alld &= flags[i];
        if (alld) break;
    }
    bf16* yp = Y + (row0 + tq) * DM + 2 * GW + h * HD + 4 * q4;
#pragma unroll
    for (int et = 0; et < 4; ++et) { v2u o; o.x = pk2(accO[et][0], accO[et][1]); o.y = pk2(accO[et][2], accO[et][3]); *(v2u*)(yp + 16 * et) = o; }
}

struct RopeIn { v4u x1, x2; f32x4 c0, c1, s0, s1; };
__device__ __forceinline__ RopeIn rope_load(const bf16* src, const float* rc, const float* rs, int pos, int part) {
    RopeIn r; r.x1 = *(const v4u*)(src + 8 * part); r.x2 = *(const v4u*)(src + 32 + 8 * part);
    r.c0 = *(const f32x4*)(rc + pos * 32 + 8 * part); r.c1 = *(const f32x4*)(rc + pos * 32 + 8 * part + 4);
    r.s0 = *(const f32x4*)(rs + pos * 32 + 8 * part); r.s1 = *(const f32x4*)(rs + pos * 32 + 8 * part + 4);
    return r;
}
__device__ __forceinline__ void rope_apply(const RopeIn& in, float (&r1)[8], float (&r2)[8]) {
    float x1[8], x2[8];
    unpack8(in.x1, x1); unpack8(in.x2, x2);
    const f32x4 c0 = in.c0, c1 = in.c1, s0 = in.s0, s1 = in.s1;
    const float cc[8] = {c0.x, c0.y, c0.z, c0.w, c1.x, c1.y, c1.z, c1.w}, ss[8] = {s0.x, s0.y, s0.z, s0.w, s1.x, s1.y, s1.z, s1.w};
#pragma unroll
    for (int i = 0; i < 8; ++i) { r1[i] = x1[i] * cc[i] - x2[i] * ss[i]; r2[i] = x1[i] * ss[i] + x2[i] * cc[i]; }
}
__device__ __forceinline__ void mixer_b_pass1(unsigned char* lds, const Params& p, const bf16* proj, int item, int tid_in) {
    int tid = tid_in; asm volatile("" : "+v"(tid));
    const int lane = tid & 63, w = __builtin_amdgcn_readfirstlane(tid >> 6), c16 = lane & 15, q4 = lane >> 4;
    const int c = item & 31, bh = item >> 5, b = bh >> 2, h = bh & 3;
    const size_t row0 = (size_t)b * SEQ;
    const float* rc = (const float*)(p.ws + WS_ROPE); const float* rs = rc + SEQ * 32;
    bf16* Kt = (bf16*)(lds + L_KS); bf16* Vt = (bf16*)(lds + L_VT);
    const float lg2 = log2f(1.f - exp2f(-5.f - (float)h));
    const RopeIn kin = rope_load(proj + (row0 + c * 128 + (tid & 127)) * DIN + 3 * GW + h * HD, rc, rs, c * 128 + (tid & 127), tid >> 7);
    const VtRegs vr = vt_load(proj + (row0 + c * 128) * DIN + 4 * GW + h * HD, tid);
    __syncthreads();
    {
        const int s = tid & 127, part = tid >> 7;
        float r1[8], r2[8];
        rope_apply(kin, r1, r2);
        const float sc = 0.125f * exp2f(lg2 * (float)(127 - s));
#pragma unroll
        for (int i = 0; i < 8; ++i) { Kt[(8 * part + i) * 136 + s] = f2bf(r1[i] * sc); Kt[(32 + 8 * part + i) * 136 + s] = f2bf(r2[i] * sc); }
    }
    vt_store(Vt, vr, tid);
    __syncthreads();
    kv_product(Kt, Vt, (float*)(p.ws + WS_KVB) + (size_t)item * 4096, w, c16, q4);
}
__device__ __forceinline__ void mixer_b_pass2(unsigned char* lds, const Params& p, const bf16* proj, bf16* Y, int l, int item, int tid_in) {
    int tid = tid_in; asm volatile("" : "+v"(tid));
    const int lane = tid & 63, w = __builtin_amdgcn_readfirstlane(tid >> 6), c16 = lane & 15, q4 = lane >> 4;
    const int c = item & 31, bh = item >> 5, b = bh >> 2, h = bh & 3;
    const size_t row0 = (size_t)b * SEQ;
    const float* rc = (const float*)(p.ws + WS_ROPE); const float* rs = rc + SEQ * 32;
    bf16* Ks = (bf16*)(lds + L_KS); bf16* Vt = (bf16*)(lds + L_VT); bf16* St = (bf16*)(lds + L_ST);
    const float lg2 = log2f(1.f - exp2f(-5.f - (float)h));
    const int tl = 16 * w + c16, pos = c * 128 + tl;
    float S[8];
    { const float* kv = (const float*)(p.ws + WS_KVB) + (size_t)item * 4096 + (8 * (tid >> 6)) * 64 + (tid & 63);
#pragma unroll
      for (int i = 0; i < 8; ++i) S[i] = kv[i * 64]; }
    const RopeIn kin = rope_load(proj + (row0 + c * 128 + (tid >> 2)) * DIN + 3 * GW + h * HD, rc, rs, c * 128 + (tid >> 2), tid & 3);
    const VtRegs vr = vt_load(proj + (row0 + c * 128) * DIN + 4 * GW + h * HD, tid);
    const RopeIn qin = rope_load(proj + (row0 + pos) * DIN + 2 * GW + h * HD, rc, rs, pos, q4);
    const float* ng = p.in[11] + l * GW + h * HD + 4 * q4;
    const bf16* gp = proj + (row0 + pos) * DIN + 5 * GW + h * HD + 4 * q4;
    f32x4 ng4[4]; v2u gg4[4];
#pragma unroll
    for (int et = 0; et < 4; ++et) { ng4[et] = *(const f32x4*)(ng + 16 * et); gg4[et] = *(const v2u*)(gp + 16 * et); }
    __syncthreads();
    {
        const int e = tid & 63, dg = tid >> 6;
        *(bf16x8*)(St + e * 72 + 8 * dg) = pack8(S);
    }
    {
        const int s = tid >> 2, part = tid & 3;
        float r1[8], r2[8];
        rope_apply(kin, r1, r2);
#pragma unroll
        for (int i = 0; i < 8; ++i) { r1[i] *= 0.125f; r2[i] *= 0.125f; }
        *(bf16x8*)(Ks + s * 72 + 8 * part) = pack8(r1); *(bf16x8*)(Ks + s * 72 + 32 + 8 * part) = pack8(r2);
    }
    vt_store(Vt, vr, tid);
    __syncthreads();
    bf16x8 Qf[2];
    { float r1[8], r2[8]; rope_apply(qin, r1, r2); Qf[0] = pack8(r1); Qf[1] = pack8(r2); }
    f32x4 accO[4];
    const float qd = exp2f(lg2 * (float)(tl + 1));
#pragma unroll
    for (int et = 0; et < 4; ++et) {
        f32x4 a = {0.f, 0.f, 0.f, 0.f};
        a = MFMA16(*(const bf16x8*)(St + (16 * et + c16) * 72 + 8 * q4), Qf[0], a);
        a = MFMA16(*(const bf16x8*)(St + (16 * et + c16) * 72 + 32 + 8 * q4), Qf[1], a);
        accO[et] = a * qd;
    }
    for (int pp = (w >> 1); pp >= 0; --pp) {
        float pv[8];
#pragma unroll
        for (int hh = 0; hh < 2; ++hh) {
            const int j = 2 * pp + hh;
            f32x4 z = {0.f, 0.f, 0.f, 0.f};
            z = MFMA16(*(const bf16x8*)(Ks + (16 * j + c16) * 72 + 8 * q4), Qf[0], z);
            z = MFMA16(*(const bf16x8*)(Ks + (16 * j + c16) * 72 + 32 + 8 * q4), Qf[1], z);
#pragma unroll
            for (int r = 0; r < 4; ++r) { const int df = tl - (16 * j + 4 * q4 + r); pv[4 * hh + r] = (df >= 0) ? z[r] * exp2f(lg2 * (float)df) : 0.f; }
        }
        const bf16x8 P = pack8(pv);
#pragma unroll
        for (int et = 0; et < 4; ++et) accO[et] = MFMA16(vt_frag2(Vt, 16 * et + c16, 2 * pp, 2 * pp + 1, q4), P, accO[et]);
    }
    float s = 0.f;
#pragma unroll
    for (int et = 0; et < 4; ++et) s += (accO[et][0] + accO[et][1]) + (accO[et][2] + accO[et][3]);
    s += __shfl_xor(s, 16); s += __shfl_xor(s, 32);
    const float mu = s * (1.f / 64.f); float qv = 0.f;
#pragma unroll
    for (int et = 0; et < 4; ++et)
#pragma unroll
        for (int r = 0; r < 4; ++r) { const float d = accO[et][r] - mu; qv += d * d; }
    qv += __shfl_xor(qv, 16); qv += __shfl_xor(qv, 32);
    const float rstd = 1.f / sqrtf(qv * (1.f / 64.f) + NORM_EPS);
    bf16* yp = Y + (row0 + pos) * DM + 1 * GW + h * HD + 4 * q4;
#pragma unroll
    for (int et = 0; et < 4; ++et) {
        const f32x4 g4 = ng4[et]; const v2u gg = gg4[et];
        const float o0 = (accO[et][0] - mu) * rstd * g4.x * siluf_(bflo(gg.x)), o1 = (accO[et][1] - mu) * rstd * g4.y * siluf_(bfhi(gg.x));
        const float o2 = (accO[et][2] - mu) * rstd * g4.z * siluf_(bflo(gg.y)), o3 = (accO[et][3] - mu) * rstd * g4.w * siluf_(bfhi(gg.y));
        v2u o; o.x = pk2(o0, o1); o.y = pk2(o2, o3); *(v2u*)(yp + 16 * et) = o;
    }
}

struct DGateIn { bf16 x[16]; float lb; };
__device__ __forceinline__ DGateIn d_gates_load(const Params& p, const bf16* proj, int l, int bh, int c, int tid) {
    const int ch = tid & 63, blk = tid >> 6, b = bh >> 2, h = bh & 3;
    const size_t row0 = (size_t)b * SEQ;
    DGateIn r; r.lb = ((const float*)(p.ws + WS_LB))[l * GW + h * HD + ch];
    const bf16* fp = proj + (row0 + c * 128 + 16 * blk) * DIN + 10 * GW + h * HD + ch;
#pragma unroll
    for (int i = 0; i < 16; ++i) r.x[i] = fp[(size_t)i * DIN];
    return r;
}
__device__ __forceinline__ void d_gates(unsigned char* lds, const DGateIn& in, int tid, float (&bl)[16], float (&kk)[16], float& bend) {
    const int ch = tid & 63, blk = tid >> 6;
    float* tot = (float*)(lds + L_TOT);
    const float lb = in.lb;
    float run = 0.f;
#pragma unroll
    for (int i = 0; i < 16; ++i) {
        float x = bf1(in.x[i]); x = fminf(fmaxf(x, -80.f), 80.f);
        const float ex = __expf(-x), sg = __builtin_amdgcn_rcpf(1.f + ex);
        const float f = lb + (1.f - lb) * sg;
        run += __logf(fmaxf(f, 1e-30f));
        bl[i] = run; kk[i] = (1.f - lb) * (ex * sg);
    }
    tot[blk * 64 + ch] = run;
    __syncthreads();
    float pre = 0.f, all = 0.f;
#pragma unroll
    for (int s = 0; s < 8; ++s) { const float t = tot[s * 64 + ch]; all += t; pre += (s < blk) ? t : 0.f; }
#pragma unroll
    for (int i = 0; i < 16; ++i) bl[i] += pre;
    bend = all;
}
__device__ __forceinline__ void mixer_d_pass1(unsigned char* lds, const Params& p, const bf16* proj, int l, int item, int tid_in) {
    int tid = tid_in; asm volatile("" : "+v"(tid));
    const int lane = tid & 63, w = __builtin_amdgcn_readfirstlane(tid >> 6), c16 = lane & 15, q4 = lane >> 4;
    const int c = item & 31, bh = item >> 5, b = bh >> 2, h = bh & 3;
    const size_t row0 = (size_t)b * SEQ;
    bf16* Kt = (bf16*)(lds + L_KS); bf16* Vt = (bf16*)(lds + L_VT);
    const DGateIn gin = d_gates_load(p, proj, l, bh, c, tid);
    const VtRegs vr = vt_load(proj + (row0 + c * 128) * DIN + 11 * GW + h * HD, tid);
    __syncthreads();
    float bl[16], kk[16], bend;
    d_gates(lds, gin, tid, bl, kk, bend);
    {
        const int ch = tid & 63, blk = tid >> 6;
        float k0[8], k1[8];
#pragma unroll
        for (int i = 0; i < 8; ++i) { k0[i] = kk[i] * __expf(bend - bl[i]); k1[i] = kk[8 + i] * __expf(bend - bl[8 + i]); }
        *(bf16x8*)(Kt + ch * 136 + 16 * blk) = pack8(k0); *(bf16x8*)(Kt + ch * 136 + 16 * blk + 8) = pack8(k1);
        if (blk == 0) ((float*)(p.ws + WS_DVEC))[(size_t)item * 64 + ch] = __expf(bend);
    }
    vt_store(Vt, vr, tid);
    __syncthreads();
    kv_product(Kt, Vt, (float*)(p.ws + WS_KVD) + (size_t)item * 4096, w, c16, q4);
}
__device__ __forceinline__ void mixer_d_pass2(unsigned char* lds, const Params& p, const bf16* proj, bf16* Y, int l, int item, int tid_in) {
    int tid = tid_in; asm volatile("" : "+v"(tid));
    const int lane = tid & 63, w = __builtin_amdgcn_readfirstlane(tid >> 6), c16 = lane & 15, q4 = lane >> 4;
    const int c = item & 31, bh = item >> 5, b = bh >> 2, h = bh & 3;
    const size_t row0 = (size_t)b * SEQ;
    bf16* Vt = (bf16*)(lds + L_VT); bf16* St = (bf16*)(lds + L_ST); float* bS = (float*)(lds + L_BS); float* kS = (float*)(lds + L_KF);
    const int tl = 16 * w + c16, pos = c * 128 + tl;
    const DGateIn gin = d_gates_load(p, proj, l, bh, c, tid);
    float S[8];
    { const float* kv = (const float*)(p.ws + WS_KVD) + (size_t)item * 4096 + (8 * (tid >> 6)) * 64 + (tid & 63);
#pragma unroll
      for (int i = 0; i < 8; ++i) S[i] = kv[i * 64]; }
    const VtRegs vr = vt_load(proj + (row0 + c * 128) * DIN + 11 * GW + h * HD, tid);
    const bf16* qp = proj + (row0 + pos) * DIN + 9 * GW + h * HD + 8 * q4;
    const v4u qr0 = *(const v4u*)qp, qr1 = *(const v4u*)(qp + 32);
    const float* ng = p.in[13] + l * GW + h * HD + 4 * q4;
    const bf16* gp = proj + (row0 + pos) * DIN + 12 * GW + h * HD + 4 * q4;
    f32x4 ng4[4]; v2u gg4[4];
#pragma unroll
    for (int et = 0; et < 4; ++et) { ng4[et] = *(const f32x4*)(ng + 16 * et); gg4[et] = *(const v2u*)(gp + 16 * et); }
    __syncthreads();
    {
        float bl[16], kk[16], bend;
        d_gates(lds, gin, tid, bl, kk, bend);
        const int ch = tid & 63, blk = tid >> 6;
#pragma unroll
        for (int i = 0; i < 16; ++i) { bS[(16 * blk + i) * 68 + ch] = bl[i]; kS[(16 * blk + i) * 68 + ch] = kk[i]; }
    }
    {
        const int e = tid & 63, dg = tid >> 6;
        *(bf16x8*)(St + e * 72 + 8 * dg) = pack8(S);
    }
    vt_store(Vt, vr, tid);
    __syncthreads();
    float qv[16], bt[16], Bp[16];
    { float a[8], bb[8]; unpack8(qr0, a); unpack8(qr1, bb);
#pragma unroll
      for (int i = 0; i < 8; ++i) { qv[i] = a[i]; qv[8 + i] = bb[i]; } }
#pragma unroll
    for (int ks = 0; ks < 2; ++ks) {
        const f32x4 b0 = *(const f32x4*)(bS + tl * 68 + 32 * ks + 8 * q4), b1 = *(const f32x4*)(bS + tl * 68 + 32 * ks + 8 * q4 + 4);
        bt[8 * ks + 0] = b0.x; bt[8 * ks + 1] = b0.y; bt[8 * ks + 2] = b0.z; bt[8 * ks + 3] = b0.w; bt[8 * ks + 4] = b1.x; bt[8 * ks + 5] = b1.y; bt[8 * ks + 6] = b1.z; bt[8 * ks + 7] = b1.w;
        if (w > 0) {
            const f32x4 p0 = *(const f32x4*)(bS + (16 * w - 1) * 68 + 32 * ks + 8 * q4), p1 = *(const f32x4*)(bS + (16 * w - 1) * 68 + 32 * ks + 8 * q4 + 4);
            Bp[8 * ks + 0] = p0.x; Bp[8 * ks + 1] = p0.y; Bp[8 * ks + 2] = p0.z; Bp[8 * ks + 3] = p0.w; Bp[8 * ks + 4] = p1.x; Bp[8 * ks + 5] = p1.y; Bp[8 * ks + 6] = p1.z; Bp[8 * ks + 7] = p1.w;
        } else {
#pragma unroll
            for (int i = 0; i < 8; ++i) Bp[8 * ks + i] = 0.f;
        }
    }
    bf16x8 Qh[2], Qt[2];
#pragma unroll
    for (int ks = 0; ks < 2; ++ks) {
        float a[8], t[8];
#pragma unroll
        for (int i = 0; i < 8; ++i) { a[i] = qv[8 * ks + i] * __expf(bt[8 * ks + i]); t[i] = qv[8 * ks + i] * __expf(bt[8 * ks + i] - Bp[8 * ks + i]); }
        Qh[ks] = pack8(a); Qt[ks] = pack8(t);
    }
    f32x4 accO[4];
#pragma unroll
    for (int et = 0; et < 4; ++et) {
        f32x4 a = {0.f, 0.f, 0.f, 0.f};
        a = MFMA16(*(const bf16x8*)(St + (16 * et + c16) * 72 + 8 * q4), Qh[0], a);
        a = MFMA16(*(const bf16x8*)(St + (16 * et + c16) * 72 + 32 + 8 * q4), Qh[1], a);
        accO[et] = a;
    }
    for (int pp = 0; 2 * pp < w; ++pp) {
        float pv[8];
#pragma unroll
        for (int hh = 0; hh < 2; ++hh) {
            const int j = 2 * pp + hh;
            if (j < w) {
                f32x4 z = {0.f, 0.f, 0.f, 0.f};
#pragma unroll
                for (int ks = 0; ks < 2; ++ks) {
                    const float* kr = kS + (16 * j + c16) * 68 + 32 * ks + 8 * q4; const float* br = bS + (16 * j + c16) * 68 + 32 * ks + 8 * q4;
                    const f32x4 k0 = *(const f32x4*)kr, k1 = *(const f32x4*)(kr + 4), b0 = *(const f32x4*)br, b1 = *(const f32x4*)(br + 4);
                    float kt[8];
                    kt[0] = k0.x * __expf(Bp[8 * ks + 0] - b0.x); kt[1] = k0.y * __expf(Bp[8 * ks + 1] - b0.y); kt[2] = k0.z * __expf(Bp[8 * ks + 2] - b0.z); kt[3] = k0.w * __expf(Bp[8 * ks + 3] - b0.w);
                    kt[4] = k1.x * __expf(Bp[8 * ks + 4] - b1.x); kt[5] = k1.y * __expf(Bp[8 * ks + 5] - b1.y); kt[6] = k1.z * __expf(Bp[8 * ks + 6] - b1.z); kt[7] = k1.w * __expf(Bp[8 * ks + 7] - b1.w);
                    z = MFMA16(pack8(kt), Qt[ks], z);
                }
#pragma unroll
                for (int r = 0; r < 4; ++r) pv[4 * hh + r] = z[r];
            } else {
#pragma unroll
                for (int r = 0; r < 4; ++r) pv[4 * hh + r] = 0.f;
            }
        }
        const bf16x8 P = pack8(pv);
#pragma unroll
        for (int et = 0; et < 4; ++et) accO[et] = MFMA16(vt_frag2(Vt, 16 * et + c16, 2 * pp, 2 * pp + 1, q4), P, accO[et]);
    }
    {
        float pd[8];
#pragma unroll
        for (int i = 0; i < 8; ++i) pd[i] = 0.f;
#pragma unroll
        for (int si = 0; si < 16; ++si) {
            const float* kr = kS + (16 * w + si) * 68 + 8 * q4; const float* br = bS + (16 * w + si) * 68 + 8 * q4;
            float v = 0.f;
#pragma unroll
            for (int ks = 0; ks < 2; ++ks) {
                const f32x4 k0 = *(const f32x4*)(kr + 32 * ks), k1 = *(const f32x4*)(kr + 32 * ks + 4), b0 = *(const f32x4*)(br + 32 * ks), b1 = *(const f32x4*)(br + 32 * ks + 4);
                v += qv[8 * ks + 0] * k0.x * __expf(fminf(bt[8 * ks + 0] - b0.x, 0.f)); v += qv[8 * ks + 1] * k0.y * __expf(fminf(bt[8 * ks + 1] - b0.y, 0.f));
                v += qv[8 * ks + 2] * k0.z * __expf(fminf(bt[8 * ks + 2] - b0.z, 0.f)); v += qv[8 * ks + 3] * k0.w * __expf(fminf(bt[8 * ks + 3] - b0.w, 0.f));
                v += qv[8 * ks + 4] * k1.x * __expf(fminf(bt[8 * ks + 4] - b1.x, 0.f)); v += qv[8 * ks + 5] * k1.y * __expf(fminf(bt[8 * ks + 5] - b1.y, 0.f));
                v += qv[8 * ks + 6] * k1.z * __expf(fminf(bt[8 * ks + 6] - b1.z, 0.f)); v += qv[8 * ks + 7] * k1.w * __expf(fminf(bt[8 * ks + 7] - b1.w, 0.f));
            }
            v += __shfl_xor(v, 16); v += __shfl_xor(v, 32);
            const float wv = (si <= c16) ? v : 0.f;
            if (q4 == (si >> 3)) pd[si & 7] = wv;
        }
        const bf16x8 P = pack8(pd);
        const bf16x8 zero8 = {0, 0, 0, 0, 0, 0, 0, 0};
#pragma unroll
        for (int et = 0; et < 4; ++et) {
            bf16x8 vf = zero8;
            if (q4 < 2) vf = *(const bf16x8*)(Vt + (16 * et + c16) * 136 + 16 * w + 8 * q4);
            accO[et] = MFMA16(vf, P, accO[et]);
        }
    }
    float ss = 0.f;
#pragma unroll
    for (int et = 0; et < 4; ++et)
#pragma unroll
        for (int r = 0; r < 4; ++r) ss += accO[et][r] * accO[et][r];
    ss += __shfl_xor(ss, 16); ss += __shfl_xor(ss, 32);
    const float rstd = 1.f / sqrtf(ss * (1.f / 64.f) + NORM_EPS);
    bf16* yp = Y + (row0 + pos) * DM + 3 * GW + h * HD + 4 * q4;
#pragma unroll
    for (int et = 0; et < 4; ++et) {
        const f32x4 g4 = ng4[et]; const v2u gg = gg4[et];
        const float o0 = accO[et][0] * rstd * g4.x * siluf_(bflo(gg.x)), o1 = accO[et][1] * rstd * g4.y * siluf_(bfhi(gg.x));
        const float o2 = accO[et][2] * rstd * g4.z * siluf_(bflo(gg.y)), o3 = accO[et][3] * rstd * g4.w * siluf_(bfhi(gg.y));
        v2u o; o.x = pk2(o0, o1); o.y = pk2(o2, o3); *(v2u*)(yp + 16 * et) = o;
    }
}

template <int PASS>
__device__ __forceinline__ void mixer_a(unsigned char* lds, const Params& p, const bf16* proj, bf16* Y, int l, int item, int tid_in) {
    int tid = tid_in; asm volatile("" : "+v"(tid));
    const int lane = tid & 63, w = __builtin_amdgcn_readfirstlane(tid >> 6), c16 = lane & 15, q4 = lane >> 4;
    const int c = item & 31, bh = item >> 5, b = bh >> 2, h = bh & 3;
    const size_t row0 = (size_t)b * SEQ;
    bf16* Xs = (bf16*)(lds + L_KS); bf16* Wat = (bf16*)(lds + L_WAT); bf16* Wxt = (bf16*)(lds + L_WXT);
    float* aS = (float*)(lds + L_AS); float* uS = (float*)(lds + L_US); float* segA = (float*)(lds + L_SEGA); float* segH = (float*)(lds + L_SEGH);
    const int ch = tid & 63, blk = tid >> 6, col = h * HD + ch;
    const float* cwp = p.in[4] + (size_t)l * 4 * GW + col;
    const float cw0 = cwp[0], cw1 = cwp[GW], cw2 = cwp[2 * GW], cw3 = cwp[3 * GW], cb = p.in[5][l * GW + col];
    const int t0 = c * 128 + 16 * blk;
    const bf16* xp = proj + (row0 + t0) * DIN + col;
    bf16 xr[16], xh0 = 0, xh1 = 0, xh2 = 0, gr[16];
    if (t0 >= 3) { xh0 = *(xp - 3 * (ptrdiff_t)DIN); xh1 = *(xp - 2 * (ptrdiff_t)DIN); xh2 = *(xp - (ptrdiff_t)DIN); }
#pragma unroll
    for (int i = 0; i < 16; ++i) xr[i] = xp[(size_t)i * DIN];
    float war[8], wxr[8];
    { const float* wa = p.in[6] + (size_t)(l * NH + h) * 4096; const float* wx = p.in[8] + (size_t)(l * NH + h) * 4096;
#pragma unroll
      for (int k = 0; k < 8; ++k) { war[k] = wa[tid + 512 * k]; wxr[k] = wx[tid + 512 * k]; } }
    float bar_[4], bxr_[4], lamr_[4];
#pragma unroll
    for (int jt = 0; jt < 4; ++jt) { const int cj = l * GW + h * HD + 16 * jt + c16; bar_[jt] = p.in[7][cj]; bxr_[jt] = p.in[9][cj]; lamr_[jt] = p.in[10][cj]; }
    float hin = 0.f;
    if (PASS == 2) {
        hin = ((const float*)(p.ws + WS_ASUM))[((size_t)item * 64 + ch) * 2 + 1];
        const bf16* gp = proj + (row0 + t0) * DIN + GW + col;
#pragma unroll
        for (int i = 0; i < 16; ++i) gr[i] = gp[(size_t)i * DIN];
    }
    __syncthreads();
    {
        float xm3 = bf1(xh0), xm2 = bf1(xh1), xm1 = bf1(xh2);
#pragma unroll
        for (int i = 0; i < 16; ++i) {
            const float x = bf1(xr[i]);
            const float xc = cb + cw0 * xm3 + cw1 * xm2 + cw2 * xm1 + cw3 * x;
            Xs[(16 * blk + i) * 72 + ch] = f2bf(xc);
            xm3 = xm2; xm2 = xm1; xm1 = x;
        }
#pragma unroll
        for (int k = 0; k < 8; ++k) { const int idx = tid + 512 * k, i = idx >> 6, j = idx & 63; Wat[j * 72 + i] = f2bf(war[k]); Wxt[j * 72 + i] = f2bf(wxr[k]); }
    }
    __syncthreads();
    {
        const bf16x8 x0 = *(const bf16x8*)(Xs + (16 * w + c16) * 72 + 8 * q4), x1 = *(const bf16x8*)(Xs + (16 * w + c16) * 72 + 32 + 8 * q4);
#pragma unroll
        for (int jt = 0; jt < 4; ++jt) {
            f32x4 ga = {0.f, 0.f, 0.f, 0.f}, gx = {0.f, 0.f, 0.f, 0.f};
            ga = MFMA16(x0, *(const bf16x8*)(Wat + (16 * jt + c16) * 72 + 8 * q4), ga); ga = MFMA16(x1, *(const bf16x8*)(Wat + (16 * jt + c16) * 72 + 32 + 8 * q4), ga);
            gx = MFMA16(x0, *(const bf16x8*)(Wxt + (16 * jt + c16) * 72 + 8 * q4), gx); gx = MFMA16(x1, *(const bf16x8*)(Wxt + (16 * jt + c16) * 72 + 32 + 8 * q4), gx);
            const int j = 16 * jt + c16;
            const float ba = bar_[jt], bx = bxr_[jt];
            const float lam = lamr_[jt];
            const float lsl = -(fmaxf(-lam, 0.f) + log1pf(__expf(-fabsf(lam))));
#pragma unroll
            for (int r = 0; r < 4; ++r) {
                const int t = 16 * w + 4 * q4 + r;
                const float rr = sigmoidf_(ga[r] + ba), ii = sigmoidf_(gx[r] + bx);
                const float la = 8.f * rr * lsl;
                const float a = __expf(la), mult = sqrtf(fmaxf(-expm1f(2.f * la), 0.f));
                aS[t * 68 + j] = a; uS[t * 68 + j] = mult * ii * bf1(Xs[t * 72 + j]);
            }
        }
    }
    __syncthreads();
    {
        float As = 1.f, Hs = 0.f;
#pragma unroll
        for (int i = 0; i < 16; ++i) { const float a = aS[(16 * blk + i) * 68 + ch], u = uS[(16 * blk + i) * 68 + ch]; Hs = a * Hs + u; As *= a; }
        segA[blk * 64 + ch] = As; segH[blk * 64 + ch] = Hs;
    }
    __syncthreads();
    float* asum = (float*)(p.ws + WS_ASUM);
    if (PASS == 1) {
        if (blk == 7) {
            float A = 1.f, H = 0.f;
#pragma unroll
            for (int s = 0; s < 8; ++s) { const float sa = segA[s * 64 + ch]; H = sa * H + segH[s * 64 + ch]; A *= sa; }
            asum[((size_t)item * 64 + ch) * 2] = A; asum[((size_t)item * 64 + ch) * 2 + 1] = H;
        }
    } else {
        float hc = hin;
        for (int s = 0; s < blk; ++s) hc = segA[s * 64 + ch] * hc + segH[s * 64 + ch];
        bf16* yp = Y + (row0 + t0) * DM + col;
#pragma unroll
        for (int i = 0; i < 16; ++i) {
            hc = aS[(16 * blk + i) * 68 + ch] * hc + uS[(16 * blk + i) * 68 + ch];
            yp[(size_t)i * DM] = f2bf(gelu_tanh_(bf1(gr[i])) * hc);
        }
    }
}

typedef __attribute__((address_space(1))) unsigned gu32;
#define XB_TMO      128
#define XB_XCNT(j)  (256  + 64 * (j))
#define XB_XSUB(j)  (1280 + 64 * (j))
#define XB_XGEN(j)  (2304 + 64 * (j))
#define XB_TOP      3328
#define XB_TOPGEN   3392
#define XCD_BAR_WORDS 3456
#define XB_SPIN_CAP (1u << 18)

__device__ __forceinline__ unsigned xb_ld(unsigned* p)              { return __hip_atomic_load(p, __ATOMIC_RELAXED, __HIP_MEMORY_SCOPE_AGENT); }
__device__ __forceinline__ unsigned xb_add(unsigned* p, unsigned v) { return __hip_atomic_fetch_add(p, v, __ATOMIC_RELAXED, __HIP_MEMORY_SCOPE_AGENT); }
__device__ __forceinline__ unsigned xb_xcc_id() { return (unsigned)__builtin_amdgcn_s_getreg((3 << 11) | 20) & 0xFu; }
#define XB_SPIN(cond, bar) do { unsigned _sp = 0; while (cond) { __builtin_amdgcn_s_sleep(1); \
    if ((++_sp & 255u) == 0u) { if (xb_ld(&(bar)[XB_TMO])) break; if (_sp > XB_SPIN_CAP) { atomicAdd(&(bar)[XB_TMO], 1u); break; } } } } while (0)

struct XcdBarrier {
    unsigned* bar; unsigned x;
    volatile LAS unsigned* st;
};

__device__ __forceinline__ XcdBarrier xcd_barrier_post(unsigned* bar, volatile LAS unsigned* st) {
    XcdBarrier b; b.bar = bar; b.x = xb_xcc_id(); b.st = st;
    if (threadIdx.x == 0) (void)xb_add(&bar[XB_XCNT(b.x)], 1u);
    return b;
}
__device__ __forceinline__ void xcd_barrier_complete(unsigned* bar, unsigned x, unsigned& nloc, unsigned& nx) {
    const unsigned G = gridDim.x * gridDim.y * gridDim.z;
    unsigned sum, cnt, mine, sp = 0u;
    for (;;) {
        sum = 0u; cnt = 0u; mine = 0u;
#pragma unroll
        for (unsigned j = 0; j < 16; ++j) { const unsigned c = xb_ld(&bar[XB_XCNT(j)]); sum += c; cnt += (c > 0u) ? 1u : 0u; mine = (j == x) ? c : mine; }
        if (sum == G) break;
        __builtin_amdgcn_s_sleep(1);
        if ((++sp & 255u) == 0u) { if (xb_ld(&bar[XB_TMO])) break; if (sp > XB_SPIN_CAP) { atomicAdd(&bar[XB_TMO], 1u); break; } }
    }
    nloc = mine > 0u ? mine : 1u; nx = cnt > 0u ? cnt : 1u;
}

__device__ __forceinline__ void xcd_barrier(const XcdBarrier& b) {
    asm volatile("s_waitcnt vmcnt(0)" ::: "memory");
    __syncthreads();
    if (threadIdx.x == 0) {
        unsigned* bar = b.bar;
        __builtin_amdgcn_s_waitcnt(0);
        unsigned nloc = b.st[0], nx = b.st[1];
        if (nloc == 0u) { xcd_barrier_complete(bar, b.x, nloc, nx); b.st[0] = nloc; b.st[1] = nx; }
        const unsigned old = xb_add(&bar[XB_XSUB(b.x)], 1u);
        const unsigned gen = old / nloc;
        if (old + 1u == (gen + 1u) * nloc) {
            __builtin_amdgcn_fence(__ATOMIC_RELEASE, "agent");
            asm volatile("s_waitcnt vmcnt(0)" ::: "memory");
            const unsigned og = xb_add(&bar[XB_TOP], 1u);
            const unsigned tg = og / nx;
            if (og + 1u == (tg + 1u) * nx) xb_add(&bar[XB_TOPGEN], 1u);
            else XB_SPIN(xb_ld(&bar[XB_TOPGEN]) == tg, bar);
            __builtin_amdgcn_fence(__ATOMIC_ACQUIRE, "agent");
            xb_add(&bar[XB_XGEN(b.x)], 1u);
            asm volatile("s_waitcnt vmcnt(0)" ::: "memory");
        } else {
            XB_SPIN(xb_ld(&bar[XB_XGEN(b.x)]) == gen, bar);
            __builtin_amdgcn_fence(__ATOMIC_ACQUIRE, "agent");
            asm volatile("s_waitcnt vmcnt(0)" ::: "memory");
        }
    }
    __syncthreads();
}


__device__ __forceinline__ void scan_phase(const Params& p, int tid) {
    const int nthr = gridDim.x * 512;
    for (int gt = blockIdx.x * 512 + tid; gt < 2 * 65536 + 1024; gt += nthr) {
        if (gt < 65536) {
            const int bh = gt >> 12, de = gt & 4095, h = bh & 3;
            const float Gam = exp2f(log2f(1.f - exp2f(-5.f - (float)h)) * 128.f);
            float* kv = (float*)(p.ws + WS_KVB) + (size_t)(bh * 32) * 4096 + de;
            float v[32];
#pragma unroll
            for (int c = 0; c < 32; ++c) v[c] = kv[(size_t)c * 4096];
            float S = 0.f;
#pragma unroll
            for (int c = 0; c < 32; ++c) { kv[(size_t)c * 4096] = S; S = Gam * S + v[c]; }
        } else if (gt < 2 * 65536) {
            const int g2 = gt - 65536, bh = g2 >> 12, de = g2 & 4095, d = de >> 6;
            float* kv = (float*)(p.ws + WS_KVD) + (size_t)(bh * 32) * 4096 + de;
            const float* dv = (const float*)(p.ws + WS_DVEC) + (size_t)(bh * 32) * 64 + d;
            float v[32], dd[32];
#pragma unroll
            for (int c = 0; c < 32; ++c) { v[c] = kv[(size_t)c * 4096]; dd[c] = dv[c * 64]; }
            float S = 0.f;
#pragma unroll
            for (int c = 0; c < 32; ++c) { kv[(size_t)c * 4096] = S; S = dd[c] * S + v[c]; }
        } else {
            const int g2 = gt - 2 * 65536, bh = g2 >> 6, ch = g2 & 63;
            float* as = (float*)(p.ws + WS_ASUM) + ((size_t)(bh * 32) * 64 + ch) * 2;
            float2 al[32];
#pragma unroll
            for (int c = 0; c < 32; ++c) al[c] = *(const float2*)(as + (size_t)c * 128);
            float H = 0.f;
#pragma unroll
            for (int c = 0; c < 32; ++c) { as[(size_t)c * 128 + 1] = H; H = al[c].x * H + al[c].y; }
        }
    }
}

__global__ void __launch_bounds__(512, 2) fwd_megakernel(Params p) {
    extern __shared__ __attribute__((aligned(16))) unsigned char lds[];
    cg::grid_group grid = cg::this_grid();
    const int G = gridDim.x;
    if (p.ws == nullptr) grid.sync();
    for (int u = threadIdx.x; u < 64; u += 512) ((volatile LAS unsigned*)((LAS unsigned char*)lds + 131072))[u] = 0u;
    __syncthreads();
    (void)xcd_barrier_post((unsigned*)(p.ws + WS_CTL) + CW_BAR, (volatile LAS unsigned*)((LAS unsigned char*)lds + 131072 + 32));
#define GRID_SYNC() do { XcdBarrier xb_; xb_.bar = (unsigned*)(p.ws + WS_CTL) + CW_BAR; xb_.x = xb_xcc_id(); xb_.st = (volatile LAS unsigned*)((LAS unsigned char*)lds + 131072 + 32); xcd_barrier(xb_); } while (0)
#define FRESH_TID() int tid = threadIdx.x; asm volatile("" : "+v"(tid)); const int lane = tid & 63, wave = tid >> 6, gw = blockIdx.x * 8 + wave, ngw = G * 8; (void)lane; (void)gw; (void)ngw;
    bf16* XN = (bf16*)(p.ws + WS_XN); bf16* PROJ = (bf16*)(p.ws + WS_PROJ); bf16* Y = (bf16*)(p.ws + WS_Y); bf16* U = (bf16*)(p.ws + WS_U);
    PG8_LAS unsigned char* glds = (PG8_LAS unsigned char*)lds;

    { FRESH_TID(); prologue(p, lds, tid); }
    GRID_SYNC();

    for (int l = 0; l < DEPTH; ++l) {
        const bf16* Wl = (const bf16*)(p.ws + WS_W + (size_t)l * W_LAYER_B);
        const bf16* Win_t = Wl; const bf16* Wout_t = Wl + (size_t)DIN * DM; const bf16* Wup_t = Wout_t + (size_t)DM * DM; const bf16* Wdn_t = Wup_t + (size_t)DFF * DM;
        {
            pg8::Gemm g{XN, Win_t, M, DIN, DM}; pg8::StaticOrder S; S.init(M, DIN, G, (int)blockIdx.x);
            pg8::EpiBf16<0> E{PROJ, DIN, nullptr, 0, 0, 1.f};
            pg8::gemm_phase<pg8::EpiBf16<0>, pg8::StaticOrder, true, true>(glds, g, S, E);
#ifdef MK_DUP_GEMM
            GRID_SYNC();
            pg8::gemm_phase<pg8::EpiBf16<0>, pg8::StaticOrder, true, true>(glds, g, S, E);
#endif
        }
        GRID_SYNC();
#if !defined(MK_SKELETON)
#ifdef MK_DUP_MIX
        for (int rep = 0; rep < 2; ++rep) {
#endif
        { FRESH_TID();
        for (int it = blockIdx.x; it < 3 * NITEM; it += G) {
            const int kind = it / NITEM, item = it % NITEM;
#ifndef MK_SKIP_D
            if (kind == 0) mixer_d_pass1(lds, p, PROJ, l, item, tid);
#endif
#ifndef MK_SKIP_B
            if (kind == 1) mixer_b_pass1(lds, p, PROJ, item, tid);
#endif
#ifndef MK_SKIP_A
            if (kind == 2) mixer_a<1>(lds, p, PROJ, Y, l, item, tid);
#endif
        } }
        GRID_SYNC();
        { FRESH_TID(); scan_phase(p, tid); }
        GRID_SYNC();
        { FRESH_TID();
        for (int it = blockIdx.x; it < 4 * NITEM; it += G) {
            const int kind = it / NITEM, item = it % NITEM;
#ifndef MK_SKIP_C
            if (kind == 0) mixer_c_item(lds, PROJ, Y, item, tid);
#endif
#ifndef MK_SKIP_D
            if (kind == 1) mixer_d_pass2(lds, p, PROJ, Y, l, item, tid);
#endif
#ifndef MK_SKIP_B
            if (kind == 2) mixer_b_pass2(lds, p, PROJ, Y, l, item, tid);
#endif
#ifndef MK_SKIP_A
            if (kind == 3) mixer_a<2>(lds, p, PROJ, Y, l, item, tid);
#endif
        } }
        __syncthreads();
#ifdef MK_DUP_MIX
        if (rep == 0) GRID_SYNC();
        }
#endif
#else
        { FRESH_TID(); for (int m = gw; m < M; m += ngw) { const v4u* s = (const v4u*)(PROJ + (size_t)m * DIN); v4u* d = (v4u*)(Y + (size_t)m * DM); d[lane] = s[lane]; d[lane + 64] = s[lane + 64]; } }
#endif
        GRID_SYNC();
        {
            pg8::Gemm g{Y, Wout_t, M, DM, DM}; pg8::StaticOrder S; S.init(M, DM, G, (int)blockIdx.x);
            pg8::EpiRes E{p.out, DM, ALPHA};
            pg8::gemm_phase<pg8::EpiRes, pg8::StaticOrder, true, true>(glds, g, S, E);
        }
        GRID_SYNC();
        { FRESH_TID(); ln_phase(p.in[15] + l * DM, p.in[16] + l * DM, p.out, XN, gw, ngw, lane); }
        GRID_SYNC();
        {
            pg8::Gemm g{XN, Wup_t, M, DFF, DM}; pg8::StaticOrder S; S.init(M, DFF, G, (int)blockIdx.x);
            pg8::EpiBf16<2> E{U, DFF, nullptr, 0, 0, 1.f};
            pg8::gemm_phase<pg8::EpiBf16<2>, pg8::StaticOrder, true, true>(glds, g, S, E);
#ifdef MK_DUP_GEMM
            GRID_SYNC();
            pg8::gemm_phase<pg8::EpiBf16<2>, pg8::StaticOrder, true, true>(glds, g, S, E);
#endif
        }
        GRID_SYNC();
        {
            pg8::Gemm g{U, Wdn_t, M, DM, DFF}; pg8::StaticOrder S; S.init(M, DM, G, (int)blockIdx.x);
            pg8::EpiRes E{p.out, DM, ALPHA};
            pg8::gemm_phase<pg8::EpiRes, pg8::StaticOrder, true, true>(glds, g, S, E);
        }
        GRID_SYNC();
        { FRESH_TID(); ln_phase(p.in[19] + l * DM, p.in[20] + l * DM, p.out, XN, gw, ngw, lane); }
        if (l + 1 < DEPTH) GRID_SYNC();
    }
}

extern "C" void kernel_launch(void* const* d_in, const int* in_sizes, int n_in, void* d_out, int out_size, void* d_ws, size_t ws_size, hipStream_t stream) {
    static int grid_blocks = 0;
    if (grid_blocks == 0) {
        if (n_in != 21 || out_size != M * DM || ws_size < WS_END) { fprintf(stderr, "kernel_launch: unexpected shapes (n_in %d out %d ws %zu)\n", n_in, out_size, ws_size); grid_blocks = -1; return; }
        int dev = 0, cus = 0, per_cu = 0;
        hipGetDevice(&dev);
        hipDeviceGetAttribute(&cus, hipDeviceAttributeMultiprocessorCount, dev);
        if (hipFuncSetAttribute((const void*)fwd_megakernel, hipFuncAttributeMaxDynamicSharedMemorySize, LDS_BYTES) != hipSuccess) { fprintf(stderr, "kernel_launch: hipFuncSetAttribute failed\n"); grid_blocks = -1; return; }
        if (hipOccupancyMaxActiveBlocksPerMultiprocessor(&per_cu, (const void*)fwd_megakernel, 512, LDS_BYTES) != hipSuccess || per_cu < 1) { fprintf(stderr, "kernel_launch: occupancy query gave %d\n", per_cu); per_cu = 1; }
        (void)hipGetLastError();
        grid_blocks = cus * 1;
        if (per_cu < 1) grid_blocks = cus;
    }
    if (grid_blocks < 0) return;
    Params p{};
    for (int i = 0; i < 21; ++i) p.in[i] = (const float*)d_in[i];
    p.out = (float*)d_out; p.ws = (unsigned char*)d_ws;
    if (hipMemsetAsync((char*)d_ws + WS_CTL, 0, CTL_ZERO_BYTES, stream) != hipSuccess) { fprintf(stderr, "kernel_launch: hipMemsetAsync failed\n"); return; }
    void* args[] = {&p};
    hipError_t e = hipLaunchCooperativeKernel((const void*)fwd_megakernel, dim3(grid_blocks), dim3(512), args, LDS_BYTES, stream);
    if (e != hipSuccess) fprintf(stderr, "cooperative launch failed: %s (grid %d)\n", hipGetErrorString(e), grid_blocks);
}
```
